# Optimizing an MI355X kernel written in HIP

```python
import math
import jax, jax.numpy as jnp
from jax import lax
import numpy as np

D_MODEL = 1024
BATCH = 16
SEQ = 4096
DEPTH = 2
DEC_BATCH = 16
DEC_SEQ = 32
PAST_LEN = 1024

CHUNK = 64
N_MEM = 256
BRANCH = 2 * D_MODEL
MIX_W = 3 * D_MODEL // 2
MEM_W = D_MODEL // 2
MEM_HEADS = 4
MEM_HD = MEM_W // MEM_HEADS
RW_HD = 64
RW_HEADS = MIX_W // RW_HD
LORA = 64
RW_PROJ = 3 * MIX_W + 2 * LORA
RW_IN = RW_PROJ + MEM_W + BRANCH
DF_HD = 64
DF_HEADS = MIX_W // (2 * DF_HD)
DF_VD = 2 * DF_HD
DF_IN = 3 * MIX_W + MEM_W + BRANCH
Q_BLOCK = 128
N_RWKV = (DEPTH + 1) // 2
N_DIFF = DEPTH // 2
EPS = 1e-6
GN_EPS = 64e-5
NEG_INF = -1e30

kernel_name = 'hybrid_rwkv7_diffattn_stream_step'


def rmsnorm(x, w):
    xf = x.astype(jnp.float32)
    y = xf * lax.rsqrt(jnp.mean(xf * xf, axis=-1, keepdims=True) + EPS)
    return (y * w.astype(jnp.float32)).astype(x.dtype)


def mem_kv(mem, norm_w, wk, wv):
    B = mem.shape[0]
    h = rmsnorm(mem, norm_w)
    return ((h @ wk).reshape(B, N_MEM, MEM_HEADS, MEM_HD),
            (h @ wv).reshape(B, N_MEM, MEM_HEADS, MEM_HD))


def mem_attention(qm, mk, mv):
    B, T, _ = qm.shape
    q = qm.reshape(B, T, MEM_HEADS, MEM_HD)
    s = jnp.einsum('bthd,bmhd->bhtm', q, mk.astype(q.dtype)).astype(jnp.float32) * MEM_HD ** -0.5
    p = jax.nn.softmax(s, axis=-1).astype(mv.dtype)
    return jnp.einsum('bhtm,bmhd->bthd', p, mv).astype(qm.dtype).reshape(B, T, MEM_W)


def rwkv_mixer(p, prev_row, S0, mu, w0, w_up, a0, a_up, k_k, k_a, r_k, ln_w, ln_b):
    B, T, _ = p.shape
    f32 = jnp.float32
    p_prev = jnp.concatenate([prev_row[:, None, :].astype(p.dtype), p[:, :-1]], axis=1)
    ps = p + mu.astype(p.dtype) * (p_prev - p)
    r, k, v, pw, pa = jnp.split(ps, [MIX_W, 2 * MIX_W, 3 * MIX_W, 3 * MIX_W + LORA], axis=-1)
    log_w = -jax.nn.softplus(-(w0 + jnp.tanh(pw) @ w_up).astype(f32)) - 0.5
    a = jax.nn.sigmoid((a0 + pa @ a_up).astype(f32))
    heads = lambda t: t.astype(f32).reshape(B, T, RW_HEADS, RW_HD)
    r, k, v, decay, a = heads(r), heads(k), heads(v), heads(jnp.exp(-jnp.exp(log_w))), heads(a)
    kk = k * k_k.astype(f32).reshape(RW_HEADS, RW_HD)
    kk = kk / jnp.maximum(jnp.linalg.norm(kk, axis=-1, keepdims=True), 1e-12)
    k = k * (1.0 + (a - 1.0) * k_a.astype(f32).reshape(RW_HEADS, RW_HD))

    def step(S, inp):
        r_t, k_t, v_t, w_t, kk_t, a_t = inp
        sa = jnp.einsum('bhvk,bhk->bhv', S, -kk_t)
        S = (S * w_t[:, :, None, :] + sa[..., None] * (kk_t * a_t)[:, :, None, :]
             + v_t[..., None] * k_t[:, :, None, :])
        return S, jnp.einsum('bhvk,bhk->bhv', S, r_t)

    xs = tuple(jnp.swapaxes(t, 0, 1) for t in (r, k, v, decay, kk, a))
    S_T, y = lax.scan(step, S0.astype(f32), xs)
    y = jnp.swapaxes(y, 0, 1)
    mean = jnp.mean(y, axis=-1, keepdims=True)
    var = jnp.mean(jnp.square(y - mean), axis=-1, keepdims=True)
    y = ((y - mean) * lax.rsqrt(var + GN_EPS) * ln_w.astype(f32).reshape(RW_HEADS, RW_HD)
         + ln_b.astype(f32).reshape(RW_HEADS, RW_HD))
    y = y + jnp.sum(r * k * r_k.astype(f32), axis=-1, keepdims=True) * v
    return y.reshape(B, T, MIX_W), S_T, p[:, -1]


def rwkv_layer(x, mk, mv, prev_row, S0, norm_w, w_out, w_in, mu, w0, w_up, a0, a_up,
               k_k, k_a, r_k, ln_w, ln_b):
    h = rmsnorm(x, norm_w)
    p, qm, gate = jnp.split(h @ w_in, [RW_PROJ, RW_PROJ + MEM_W], axis=-1)
    y_mix, S_T, last_row = rwkv_mixer(p, prev_row, S0, mu, w0, w_up, a0, a_up, k_k, k_a, r_k, ln_w, ln_b)
    y_mem = mem_attention(qm, mk, mv)
    out = jnp.concatenate([y_mix.astype(x.dtype), y_mem], axis=-1) * jax.nn.silu(gate)
    return x + out @ w_out, S_T, last_row


def diff_attention(q, k_all, v_all, q_pos, k_pos, lam):
    q1, q2 = jnp.split(q, 2, axis=-1)
    k1, k2 = jnp.split(k_all, 2, axis=-1)
    mask = k_pos[None, :] < (q_pos[:, None] // CHUNK + 1) * CHUNK

    def probs(qa, ka):
        s = jnp.einsum('bqhd,bkhd->bhqk', qa, ka).astype(jnp.float32) * DF_HD ** -0.5
        return jax.nn.softmax(jnp.where(mask, s, NEG_INF), axis=-1)

    attn = probs(q1, k1) - lam * probs(q2, k2)
    return jnp.einsum('bhqk,bkhd->bqhd', attn.astype(v_all.dtype), v_all)


def diff_layer(x, mk, mv, k_past, v_past, layer_idx, norm_w, w_out, w_in, lq1, lk1, lq2, lk2, subln):
    B, T, _ = x.shape
    h = rmsnorm(x, norm_w)
    q, k, v, qm, gate = jnp.split(h @ w_in, [MIX_W, 2 * MIX_W, 3 * MIX_W, 3 * MIX_W + MEM_W], axis=-1)
    q = q.reshape(B, T, DF_HEADS, 2 * DF_HD)
    k = k.reshape(B, T, DF_HEADS, 2 * DF_HD)
    v = v.reshape(B, T, DF_HEADS, DF_VD)
    if k_past is None:
        past, k_all, v_all = 0, k, v
    else:
        past = k_past.shape[1]
        k_all = jnp.concatenate([k_past.astype(k.dtype), k], axis=1)
        v_all = jnp.concatenate([v_past.astype(v.dtype), v], axis=1)
    lam_init = 0.8 - 0.6 * math.exp(-0.3 * layer_idx)
    f32 = jnp.float32
    lam = (jnp.exp(jnp.sum(lq1.astype(f32) * lk1.astype(f32)))
           - jnp.exp(jnp.sum(lq2.astype(f32) * lk2.astype(f32))) + lam_init)
    blocks = []
    for s in range(0, T, Q_BLOCK):
        e = min(s + Q_BLOCK, T)
        q_pos = past + jnp.arange(s, e)
        k_pos = jnp.arange(past + e)
        blocks.append(diff_attention(q[:, s:e], k_all[:, :past + e], v_all[:, :past + e], q_pos, k_pos, lam))
    o = jnp.concatenate(blocks, axis=1)
    o = rmsnorm(o, subln) * (1.0 - lam_init)
    y_mem = mem_attention(qm, mk, mv)
    out = jnp.concatenate([o.reshape(B, T, MIX_W).astype(x.dtype), y_mem], axis=-1) * jax.nn.silu(gate)
    return x + out @ w_out, k, v


def setup_inputs(seed: int = 0) -> dict:
    key = jax.random.key(seed)
    ks = iter(jax.random.split(key, 40))
    f32 = jnp.float32
    nrm = lambda shape, scale: jax.random.normal(next(ks), shape, f32) * scale
    uni = lambda shape, lo, hi: jax.random.uniform(next(ks), shape, f32, lo, hi)
    return {
        'x_prompt': nrm((BATCH, SEQ, D_MODEL), 1.0),
        'mem_prompt': nrm((BATCH, N_MEM, D_MODEL), 1.0),
        'x_sample': nrm((DEC_BATCH, DEC_SEQ, D_MODEL), 1.0),
        'state_rwkv': nrm((N_RWKV, DEC_BATCH, RW_HEADS, RW_HD, RW_HD), 0.1),
        'state_shift': nrm((N_RWKV, DEC_BATCH, RW_PROJ), 1.0),
        'cache_k': nrm((N_DIFF, DEC_BATCH, PAST_LEN, DF_HEADS, 2 * DF_HD), 1.0),
        'cache_v': nrm((N_DIFF, DEC_BATCH, PAST_LEN, DF_HEADS, DF_VD), 1.0),
        'cache_mem_k': nrm((DEPTH, DEC_BATCH, N_MEM, MEM_HEADS, MEM_HD), 1.0),
        'cache_mem_v': nrm((DEPTH, DEC_BATCH, N_MEM, MEM_HEADS, MEM_HD), 1.0),
        'norm_w': 1.0 + nrm((DEPTH, D_MODEL), 0.02),
        'mem_norm_w': 1.0 + nrm((DEPTH, D_MODEL), 0.02),
        'w_mem_k': nrm((DEPTH, D_MODEL, MEM_W), D_MODEL ** -0.5),
        'w_mem_v': nrm((DEPTH, D_MODEL, MEM_W), D_MODEL ** -0.5),
        'w_out': nrm((DEPTH, BRANCH, D_MODEL), 0.5 * BRANCH ** -0.5),
        'final_norm_w': 1.0 + nrm((D_MODEL,), 0.02),
        'rw_in': nrm((N_RWKV, D_MODEL, RW_IN), D_MODEL ** -0.5),
        'rw_mu': uni((N_RWKV, RW_PROJ), 0.0, 1.0),
        'rw_w0': uni((N_RWKV, MIX_W), -6.0, 0.0),
        'rw_w_up': nrm((N_RWKV, LORA, MIX_W), 0.1),
        'rw_a0': nrm((N_RWKV, MIX_W), 0.5),
        'rw_a_up': nrm((N_RWKV, LORA, MIX_W), 0.1),
        'rw_k_k': 0.85 + nrm((N_RWKV, MIX_W), 0.02),
        'rw_k_a': 1.0 + nrm((N_RWKV, MIX_W), 0.02),
        'rw_r_k': nrm((N_RWKV, RW_HEADS, RW_HD), 0.1),
        'rw_ln_w': 1.0 + nrm((N_RWKV, MIX_W), 0.02),
        'rw_ln_b': nrm((N_RWKV, MIX_W), 0.02),
        'df_in': nrm((N_DIFF, D_MODEL, DF_IN), D_MODEL ** -0.5),
        'df_lq1': nrm((N_DIFF, DF_HD), 0.1),
        'df_lk1': nrm((N_DIFF, DF_HD), 0.1),
        'df_lq2': nrm((N_DIFF, DF_HD), 0.1),
        'df_lk2': nrm((N_DIFF, DF_HD), 0.1),
        'df_subln': 1.0 + nrm((N_DIFF, DF_VD), 0.02),
    }


def reference(x_prompt, mem_prompt, x_sample, state_rwkv, state_shift, cache_k, cache_v,
              cache_mem_k, cache_mem_v, norm_w, mem_norm_w, w_mem_k, w_mem_v, w_out, final_norm_w,
              rw_in, rw_mu, rw_w0, rw_w_up, rw_a0, rw_a_up, rw_k_k, rw_k_a, rw_r_k, rw_ln_w, rw_ln_b,
              df_in, df_lq1, df_lk1, df_lq2, df_lk2, df_subln):
    xp, xs = x_prompt, x_sample
    Bp = xp.shape[0]
    p_S, p_shift, p_k, p_v, p_mk, p_mv = [], [], [], [], [], []
    s_S, s_shift, s_k, s_v = [], [], [], []
    for i in range(DEPTH):
        j = i // 2
        mkp, mvp = mem_kv(mem_prompt, mem_norm_w[i], w_mem_k[i], w_mem_v[i])
        p_mk.append(mkp)
        p_mv.append(mvp)
        if i % 2 == 0:
            rw = (rw_in[j], rw_mu[j], rw_w0[j], rw_w_up[j], rw_a0[j], rw_a_up[j],
                  rw_k_k[j], rw_k_a[j], rw_r_k[j], rw_ln_w[j], rw_ln_b[j])
            zero_row = jnp.zeros((Bp, RW_PROJ), xp.dtype)
            zero_S = jnp.zeros((Bp, RW_HEADS, RW_HD, RW_HD), jnp.float32)
            xp, Sp, rp = rwkv_layer(xp, mkp, mvp, zero_row, zero_S, norm_w[i], w_out[i], *rw)
            xs, Ss, rs = rwkv_layer(xs, cache_mem_k[i], cache_mem_v[i], state_shift[j], state_rwkv[j],
                                    norm_w[i], w_out[i], *rw)
            p_S.append(Sp)
            p_shift.append(rp)
            s_S.append(Ss)
            s_shift.append(rs)
        else:
            df = (df_in[j], df_lq1[j], df_lk1[j], df_lq2[j], df_lk2[j], df_subln[j])
            xp, kp, vp = diff_layer(xp, mkp, mvp, None, None, i, norm_w[i], w_out[i], *df)
            xs, ks_, vs_ = diff_layer(xs, cache_mem_k[i], cache_mem_v[i], cache_k[j], cache_v[j], i,
                                      norm_w[i], w_out[i], *df)
            p_k.append(kp)
            p_v.append(vp)
            s_k.append(ks_)
            s_v.append(vs_)
    y_prompt = rmsnorm(xp, final_norm_w)
    y_sample = rmsnorm(xs, final_norm_w)
    return (y_prompt, y_sample, jnp.stack(p_S), jnp.stack(p_shift), jnp.stack(p_k), jnp.stack(p_v),
            jnp.stack(p_mk), jnp.stack(p_mv), jnp.stack(s_S), jnp.stack(s_shift), jnp.stack(s_k), jnp.stack(s_v))
```

```cpp
#include <hip/hip_runtime.h>
#include <hip/hip_cooperative_groups.h>
#include <cstdio>
#include <cstdint>
namespace cg = cooperative_groups;

typedef unsigned short bf16_t;
typedef short bf16x8 __attribute__((ext_vector_type(8)));
typedef short s16x4 __attribute__((ext_vector_type(4)));
typedef float f32x16 __attribute__((ext_vector_type(16)));
typedef float f32x4 __attribute__((ext_vector_type(4)));
typedef float f32x2 __attribute__((ext_vector_type(2)));
typedef unsigned u32x4 __attribute__((ext_vector_type(4)));
typedef unsigned u32x2 __attribute__((ext_vector_type(2)));
typedef _Float16 h16x4 __attribute__((ext_vector_type(4)));
#define LAS __attribute__((address_space(3)))

constexpr int DM = 1024, MP = 65536, MS = 512, MT = MP + MS  ;
constexpr int RWP = 4736, RWIN = 7296, RWIN_PAD = 7424, DFIN = 7168, MIXW = 1536, BR = 2048;
constexpr int NTHR = 512;
constexpr int LDS_BYTES = 147456;

constexpr size_t O_Y = 0, O_YS = 67108864, O_PS = O_YS + 524288, O_PSH = O_PS + 1572864, O_PK = O_PSH + 75776,
                 O_PV = O_PK + 100663296, O_PMK = O_PV + 100663296, O_PMV = O_PMK + 4194304, O_SS = O_PMV + 4194304,
                 O_SSH = O_SS + 1572864, O_SK = O_SSH + 75776, O_SV = O_SK + 786432;
constexpr size_t T_HB = 0, T_D0 = (size_t)MT * DM * 2, T_P0 = O_PK * 4;
constexpr size_t T_SK = 0, T_SV = (size_t)16 * 1088 * MIXW * 2;
constexpr size_t WS_RWIN_T = 0;
constexpr size_t WS_DFIN_T = WS_RWIN_T + (size_t)RWIN_PAD * 1024 * 2;
constexpr size_t WS_WOUT_T = WS_DFIN_T + (size_t)DFIN * 1024 * 2;
constexpr size_t WS_WMEM_T = WS_WOUT_T + (size_t)2 * 1024 * 2048 * 2;
constexpr size_t WS_WUP_T = WS_WMEM_T + (size_t)2 * 1024 * 1024 * 2;
constexpr size_t WS_AUP_T = WS_WUP_T + (size_t)1536 * 64 * 2;
constexpr size_t WS_HM = WS_AUP_T + (size_t)1536 * 64 * 2;
constexpr size_t WS_MKB = WS_HM + (size_t)2 * 4096 * 1024 * 2;
constexpr size_t WS_MVB = WS_MKB + (size_t)2 * 8192 * 512 * 2;
constexpr size_t WS_BRANCH = WS_MVB + (size_t)2 * 8192 * 512 * 2;
constexpr size_t WS_GATE = WS_BRANCH + (size_t)MT * BR * 2;
constexpr size_t WS_KB = WS_GATE + (size_t)MT * BR * 2;
constexpr size_t WS_VB = WS_KB + (size_t)MT * MIXW * 2;
constexpr size_t WS_END = WS_VB + (size_t)MT * MIXW * 2;
constexpr size_t WS_EARR = WS_KB, WS_AARR = WS_VB, WS_X2 = WS_KB;

struct Args {
    const float* in[32];
    float* out;
    unsigned char* ws;
    int ph_lo, ph_hi;
};

typedef __bf16 nbf16x2 __attribute__((ext_vector_type(2)));
__device__ __forceinline__ unsigned pk_bf16(float lo, float hi) { const f32x2 v = {lo, hi}; return __builtin_bit_cast(unsigned, __builtin_convertvector(v, nbf16x2)); }
__device__ __forceinline__ bf16_t f2bf(float f) { return (bf16_t)(pk_bf16(f, 0.f) & 0xffffu); }
__device__ __forceinline__ float bf2f(bf16_t b) { return __uint_as_float(((unsigned)b) << 16); }
__device__ __forceinline__ float bflo(unsigned w) { return __uint_as_float(w << 16); }
__device__ __forceinline__ float bfhi(unsigned w) { return __uint_as_float(w & 0xffff0000u); }
__device__ __forceinline__ float dpp_f(float v, const int ctrl_sel) {
    const int x = __float_as_int(v);
    int r;
    if (ctrl_sel == 0) r = __builtin_amdgcn_update_dpp(x, x, 0xB1, 0xF, 0xF, false);
    else if (ctrl_sel == 1) r = __builtin_amdgcn_update_dpp(x, x, 0x4E, 0xF, 0xF, false);
    else if (ctrl_sel == 2) r = __builtin_amdgcn_update_dpp(x, x, 0x124, 0xF, 0xF, false);
    else r = __builtin_amdgcn_update_dpp(x, x, 0x128, 0xF, 0xF, false);
    return __int_as_float(r);
}
__device__ __forceinline__ float wave_sum(float v) {
    v += dpp_f(v, 0); v += dpp_f(v, 1); v += dpp_f(v, 2); v += dpp_f(v, 3);
    v += __shfl_xor(v, 16); v += __shfl_xor(v, 32);
    return v;
}
__device__ __forceinline__ const float* xrow(const Args& a, int row) { return row < MP ? a.in[0] + (size_t)row * DM : a.in[2] + (size_t)(row - MP) * DM; }

template <class T> __device__ __forceinline__ void launder(T*& p) { asm volatile("" : "+s"(p)); }

__device__ __forceinline__ void tr_tile(const float* __restrict__ W, int ldw, int k0, int n0, bf16_t* __restrict__ Wt, int ldt, int roff, float* tl) {
    const int tid = threadIdx.x;
#pragma unroll
    for (int i = 0; i < 8; ++i) { const int idx = tid + NTHR * i, k = idx >> 6, n = idx & 63; tl[k * 65 + n] = W[(size_t)(k0 + k) * ldw + n0 + n]; }
    __syncthreads();
#pragma unroll
    for (int i = 0; i < 8; ++i) { const int idx = tid + NTHR * i, n = idx >> 6, k = idx & 63; Wt[(size_t)(roff + n0 + n) * ldt + k0 + k] = f2bf(tl[k * 65 + n]); }
    __syncthreads();
}

__device__ __forceinline__ void norm_row_bf16(const float* __restrict__ x, const bf16_t* __restrict__ add, const float* __restrict__ w0, bf16_t* __restrict__ o0,
                                              const float* __restrict__ w1, bf16_t* __restrict__ o1, int lane) {
    f32x4 v[4]; float ss = 0.f;
#pragma unroll
    for (int i = 0; i < 4; ++i) {
        const int c = i * 256 + lane * 4;
        v[i] = *(const f32x4*)(x + c);
        if (add) { const u32x2 d = *(const u32x2*)(add + c); v[i][0] += bflo(d.x); v[i][1] += bfhi(d.x); v[i][2] += bflo(d.y); v[i][3] += bfhi(d.y); }
        ss += v[i][0] * v[i][0] + v[i][1] * v[i][1] + v[i][2] * v[i][2] + v[i][3] * v[i][3];
    }
    ss = wave_sum(ss);
    const float rs = rsqrtf(ss * (1.0f / 1024.0f) + 1e-6f);
#pragma unroll
    for (int i = 0; i < 4; ++i) {
        const int c = i * 256 + lane * 4;
        const f32x4 g = *(const f32x4*)(w0 + c);
        u32x2 o; o.x = pk_bf16(v[i][0] * rs * g[0], v[i][1] * rs * g[1]); o.y = pk_bf16(v[i][2] * rs * g[2], v[i][3] * rs * g[3]);
        *(u32x2*)(o0 + c) = o;
        if (w1) { const f32x4 g1 = *(const f32x4*)(w1 + c);
            u32x2 q; q.x = pk_bf16(v[i][0] * rs * g1[0], v[i][1] * rs * g1[1]); q.y = pk_bf16(v[i][2] * rs * g1[2], v[i][3] * rs * g1[3]);
            *(u32x2*)(o1 + c) = q; }
    }
}

__device__ __forceinline__ void phase_prep(const Args& a, unsigned char* lds) {
    const int tid = threadIdx.x, wid = tid >> 6, lane = tid & 63;
    float* tl = (float*)lds;
    unsigned char* ws = a.ws;
    for (int j = blockIdx.x; j < 5200; j += gridDim.x) {
        const float* W; int ldw, kt, nt, ldt, roff; bf16_t* Wt; int r = j;
        if (r < 1824) { W = a.in[15]; ldw = RWIN; kt = r / 114; nt = r % 114; Wt = (bf16_t*)(ws + WS_RWIN_T); ldt = 1024; roff = 0; }
        else if (r < 1824 + 1792) { r -= 1824; W = a.in[26]; ldw = DFIN; kt = r / 112; nt = r % 112; Wt = (bf16_t*)(ws + WS_DFIN_T); ldt = 1024; roff = 0; }
        else if (r < 1824 + 1792 + 1024) { r -= 1824 + 1792; const int li = r >> 9; r &= 511; W = a.in[13] + (size_t)li * 2048 * 1024; ldw = 1024; kt = r / 16; nt = r % 16;
            Wt = (bf16_t*)(ws + WS_WOUT_T) + (size_t)li * 1024 * 2048; ldt = 2048; roff = 0; }
        else if (r < 1824 + 1792 + 1024 + 512) { r -= 1824 + 1792 + 1024; const int which = r >> 7, li = which >> 1, kv = which & 1; r &= 127;
            W = (kv ? a.in[12] : a.in[11]) + (size_t)li * 1024 * 512; ldw = 512; kt = r / 8; nt = r % 8;
            Wt = (bf16_t*)(ws + WS_WMEM_T) + (size_t)li * 1024 * 1024; ldt = 1024; roff = kv * 512; }
        else { r -= 1824 + 1792 + 1024 + 512; const int which = r / 24; nt = r % 24; kt = 0; W = which ? a.in[20] : a.in[18]; ldw = 1536;
            Wt = (bf16_t*)(ws + (which ? WS_AUP_T : WS_WUP_T)); ldt = 64; roff = 0; }
        tr_tile(W, ldw, kt * 64, nt * 64, Wt, ldt, roff, tl);
    }
    {
        u32x4* z = (u32x4*)(ws + WS_RWIN_T + (size_t)RWIN * 1024 * 2);
        const int n = (RWIN_PAD - RWIN) * 1024 * 2 / 16;
        for (int i = blockIdx.x * NTHR + tid; i < n; i += gridDim.x * NTHR) z[i] = (u32x4){0u, 0u, 0u, 0u};
    }
    {
        const int gw = blockIdx.x * 8 + wid, nw = gridDim.x * 8;
        bf16_t* HB = (bf16_t*)((unsigned char*)a.out + T_HB);
        bf16_t* HM = (bf16_t*)(ws + WS_HM);
        for (int r = gw; r < MT + 4096; r += nw) {
            if (r < MT) norm_row_bf16(xrow(a, r), nullptr, a.in[9], HB + (size_t)r * DM, nullptr, nullptr, lane);
            else { const int m = r - MT; norm_row_bf16(a.in[1] + (size_t)m * DM, nullptr, a.in[10], HM + (size_t)m * DM, a.in[10] + DM, HM + (size_t)(4096 + m) * DM, lane); }
        }
    }
    {
        const size_t n4 = (size_t)2 * 4096 * 512 / 4;
        for (size_t i = (size_t)blockIdx.x * NTHR + tid; i < 2 * n4; i += (size_t)gridDim.x * NTHR) {
            const int kv = i >= n4; const size_t e = (kv ? i - n4 : i) * 4;
            const int li = (int)(e / (4096 * 512)); const size_t rem = e % ((size_t)4096 * 512);
            const f32x4 v = *(const f32x4*)((kv ? a.in[8] : a.in[7]) + e);
            bf16_t* dst = (bf16_t*)(ws + (kv ? WS_MVB : WS_MKB)) + (size_t)li * 8192 * 512 + (size_t)4096 * 512 + rem;
            u32x2 o; o.x = pk_bf16(v[0], v[1]); o.y = pk_bf16(v[2], v[3]); *(u32x2*)dst = o;
        }
    }
}

__device__ __forceinline__ bool unit_next(int nM, int nN, int i, int G, int c, int& pm, int& pn) {
    const int nwg = nM * nN; const long L = (long)i * G + c; if (L >= nwg) return false;
    int wgid = (int)L; { const int q = nwg / 8, r = nwg % 8, xcd = wgid % 8, off = wgid / 8; wgid = (xcd < r ? xcd * (q + 1) : r * (q + 1) + (xcd - r) * q) + off; }
    const int nig = 8 * nN, gid = wgid / nig, fm = gid * 8, gsz = (nM - fm) < 8 ? (nM - fm) : 8;
    pm = fm + ((wgid % nig) % gsz); pn = (wgid % nig) / gsz; return true;
}

__device__ __forceinline__ u32x2 pk4(const f32x4 v) { return (u32x2){pk_bf16(v[0], v[1]), pk_bf16(v[2], v[3])}; }
__device__ __forceinline__ void st8_bf16(bf16_t* p, const f32x4 a, const f32x4 b) { __builtin_nontemporal_store((u32x4){pk_bf16(a[0], a[1]), pk_bf16(a[2], a[3]), pk_bf16(b[0], b[1]), pk_bf16(b[2], b[3])}, (u32x4*)p); }
__device__ __forceinline__ void st8_f32(float* p, const f32x4 a, const f32x4 b) { __builtin_nontemporal_store(a, (f32x4*)p); __builtin_nontemporal_store(b, (f32x4*)(p + 4)); }
__device__ __forceinline__ f32x4 silu4(const f32x4 v) { return (f32x4){v[0] / (1.f + __expf(-v[0])), v[1] / (1.f + __expf(-v[1])), v[2] / (1.f + __expf(-v[2])), v[3] / (1.f + __expf(-v[3]))}; }
struct EpiMem {
    float* out; unsigned char* ws; int li;
    __device__ __forceinline__ void wash() { launder(out); launder(ws); }
    __device__ __forceinline__ void store4(int row, int col, const f32x4 v) const {
        const size_t o = (size_t)li * 4096 * 512 + (size_t)row * 512, ob16 = (size_t)li * 8192 * 512 + (size_t)row * 512;
        if (col < 512) { __builtin_nontemporal_store(v, (f32x4*)(out + O_PMK + o + col)); __builtin_nontemporal_store(pk4(v), (u32x2*)((bf16_t*)(ws + WS_MKB) + ob16 + col)); }
        else { __builtin_nontemporal_store(v, (f32x4*)(out + O_PMV + o + col - 512)); __builtin_nontemporal_store(pk4(v), (u32x2*)((bf16_t*)(ws + WS_MVB) + ob16 + col - 512)); }
    }
    __device__ __forceinline__ void store8(int row, int col, const f32x4 v, const f32x4 w) const {
        const size_t o = (size_t)li * 4096 * 512 + (size_t)row * 512, ob16 = (size_t)li * 8192 * 512 + (size_t)row * 512;
        if (col < 512) { st8_f32(out + O_PMK + o + col, v, w); st8_bf16((bf16_t*)(ws + WS_MKB) + ob16 + col, v, w); }
        else { st8_f32(out + O_PMV + o + col - 512, v, w); st8_bf16((bf16_t*)(ws + WS_MVB) + ob16 + col - 512, v, w); }
    }
};
struct EpiIn0 {
    float* out; unsigned char* ws;
    __device__ __forceinline__ void wash() { launder(out); launder(ws); }
    __device__ __forceinline__ void store4(int row, int col, const f32x4 v) const {
        if (col < RWP) {
            __builtin_nontemporal_store(pk4(v), (u32x2*)((bf16_t*)((unsigned char*)out + T_P0) + (size_t)row * RWP + col));
            if (row < MP) { if ((row & 4095) == 4095) *(f32x4*)(out + O_PSH + (size_t)(row >> 12) * RWP + col) = v; }
            else { const int r2 = row - MP; if ((r2 & 31) == 31) *(f32x4*)(out + O_SSH + (size_t)(r2 >> 5) * RWP + col) = v; }
        } else if (col < RWP + 512) __builtin_nontemporal_store(pk4(v), (u32x2*)((bf16_t*)(ws + WS_BRANCH) + (size_t)row * BR + 1536 + (col - RWP)));
        else if (col < RWIN) __builtin_nontemporal_store(pk4(silu4(v)), (u32x2*)((bf16_t*)(ws + WS_GATE) + (size_t)row * BR + (col - RWP - 512)));
    }
    __device__ __forceinline__ void store8(int row, int col, const f32x4 v, const f32x4 w) const {
        if (col < RWP) {
            st8_bf16((bf16_t*)((unsigned char*)out + T_P0) + (size_t)row * RWP + col, v, w);
            if (row < MP) { if ((row & 4095) == 4095) { float* p = out + O_PSH + (size_t)(row >> 12) * RWP + col; *(f32x4*)p = v; *(f32x4*)(p + 4) = w; } }
            else { const int r2 = row - MP; if ((r2 & 31) == 31) { float* p = out + O_SSH + (size_t)(r2 >> 5) * RWP + col; *(f32x4*)p = v; *(f32x4*)(p + 4) = w; } }
        } else if (col < RWP + 512) st8_bf16((bf16_t*)(ws + WS_BRANCH) + (size_t)row * BR + 1536 + (col - RWP), v, w);
        else if (col < RWIN) st8_bf16((bf16_t*)(ws + WS_GATE) + (size_t)row * BR + (col - RWP - 512), silu4(v), silu4(w));
    }
};
struct EpiIn1 {
    float* out; unsigned char* ws;
    __device__ __forceinline__ void wash() { launder(out); launder(ws); }
    __device__ __forceinline__ void store4(int row, int col, const f32x4 v) const {
        if (col < 1536) __builtin_nontemporal_store(pk4(v), (u32x2*)((bf16_t*)(ws + WS_BRANCH) + (size_t)row * BR + col));
        else if (col < 3072) { const int c = col - 1536; __builtin_nontemporal_store(pk4(v), (u32x2*)((bf16_t*)(ws + WS_KB) + (size_t)row * MIXW + c));
            if (row < MP) __builtin_nontemporal_store(v, (f32x4*)(out + O_PK + (size_t)row * MIXW + c)); else __builtin_nontemporal_store(v, (f32x4*)(out + O_SK + (size_t)(row - MP) * MIXW + c)); }
        else if (col < 4608) { const int c = col - 3072; __builtin_nontemporal_store(pk4(v), (u32x2*)((bf16_t*)(ws + WS_VB) + (size_t)row * MIXW + c));
            if (row < MP) __builtin_nontemporal_store(v, (f32x4*)(out + O_PV + (size_t)row * MIXW + c)); else __builtin_nontemporal_store(v, (f32x4*)(out + O_SV + (size_t)(row - MP) * MIXW + c)); }
        else if (col < 5120) __builtin_nontemporal_store(pk4(v), (u32x2*)((bf16_t*)(ws + WS_BRANCH) + (size_t)row * BR + 1536 + (col - 4608)));
        else __builtin_nontemporal_store(pk4(silu4(v)), (u32x2*)((bf16_t*)(ws + WS_GATE) + (size_t)row * BR + (col - 5120)));
    }
    __device__ __forceinline__ void store8(int row, int col, const f32x4 v, const f32x4 w) const {
        if (col < 1536) st8_bf16((bf16_t*)(ws + WS_BRANCH) + (size_t)row * BR + col, v, w);
        else if (col < 3072) { const int c = col - 1536; st8_bf16((bf16_t*)(ws + WS_KB) + (size_t)row * MIXW + c, v, w);
            if (row < MP) st8_f32(out + O_PK + (size_t)row * MIXW + c, v, w); else st8_f32(out + O_SK + (size_t)(row - MP) * MIXW + c, v, w); }
        else if (col < 4608) { const int c = col - 3072; st8_bf16((bf16_t*)(ws + WS_VB) + (size_t)row * MIXW + c, v, w);
            if (row < MP) st8_f32(out + O_PV + (size_t)row * MIXW + c, v, w); else st8_f32(out + O_SV + (size_t)(row - MP) * MIXW + c, v, w); }
        else if (col < 5120) st8_bf16((bf16_t*)(ws + WS_BRANCH) + (size_t)row * BR + 1536 + (col - 4608), v, w);
        else st8_bf16((bf16_t*)(ws + WS_GATE) + (size_t)row * BR + (col - 5120), silu4(v), silu4(w));
    }
};
struct EpiOut0 {
    float* out;
    __device__ __forceinline__ void wash() { launder(out); }
    __device__ __forceinline__ void store4(int row, int col, const f32x4 v) const { __builtin_nontemporal_store(pk4(v), (u32x2*)((bf16_t*)((unsigned char*)out + T_D0) + (size_t)row * DM + col)); }
    __device__ __forceinline__ void store8(int row, int col, const f32x4 v, const f32x4 w) const { st8_bf16((bf16_t*)((unsigned char*)out + T_D0) + (size_t)row * DM + col, v, w); }
};
struct EpiOut1 {
    const float* xp; const float* xs; float* out; unsigned char* ws;
    __device__ __forceinline__ void wash() { launder(xp); launder(xs); launder(out); launder(ws); }
    __device__ __forceinline__ void store4(int row, int col, const f32x4 v) const {
        const f32x4 x = row < MP ? *(const f32x4*)(xp + (size_t)row * DM + col) : *(const f32x4*)(xs + (size_t)(row - MP) * DM + col);
        const u32x2 d = *(const u32x2*)((const bf16_t*)((const unsigned char*)out + T_D0) + (size_t)row * DM + col);
        const f32x4 d0 = {bflo(d.x), bfhi(d.x), bflo(d.y), bfhi(d.y)};
        __builtin_nontemporal_store(x + d0 + v, (f32x4*)((float*)(ws + WS_X2) + (size_t)row * DM + col));
    }
    __device__ __forceinline__ void store8(int row, int col, const f32x4 v, const f32x4 w) const { store4(row, col, v); store4(row, col + 4, w); }
};

namespace pg8 {
#define PG8_LAS __attribute__((address_space(3)))
typedef unsigned short bf16_t;
typedef short bf16x8 __attribute__((ext_vector_type(8)));
typedef float f32x4 __attribute__((ext_vector_type(4)));
typedef unsigned u32x4 __attribute__((ext_vector_type(4)));
constexpr int BM = 256, BK = 64, HALF = 128, HTB = HALF * BK * 2  , STAGE_BYTES = 8 * HTB, NXCD = 8, WGM = 8;

__host__ __device__ __forceinline__ int lds_byte(int r, int c) { const int st = (r >> 4) * 2 + (c >> 5), rr = r & 15, cc = c & 31, ob = rr * 64 + cc * 2; return st * 1024 + (ob ^ (((ob >> 9) & 1) << 5)); }
__host__ __device__ __forceinline__ void stage_rc(int b, int& R, int& C) { const int st = b / 1024, sb = b % 1024, swz = sb ^ (((sb >> 9) & 1) << 5); R = (st >> 1) * 16 + swz / 64; C = (st & 1) * 32 + (swz % 64) / 2; }
__host__ __device__ __forceinline__ int perm32(int rho) { const int n = rho >> 4, i = rho & 15; return 8 * (i >> 2) + 4 * n + (i & 3); }

struct Unit { int pm, pn; };
struct Gemm { const bf16_t* A; const bf16_t* Bt; int M, N, K; };

struct StaticOrder {
    int nM, nN, nwg, G, c;
    __host__ __device__ __forceinline__ void init(int M, int N, int G_, int c_) { nM = M / BM; nN = N / BM; nwg = nM * nN; G = G_; c = c_; }
    __host__ __device__ __forceinline__ bool next(int i, Unit& u) const {
        const long L = (long)i * G + c; if (L >= nwg) return false;
        int wgid = (int)L; { const int q = nwg / NXCD, r = nwg % NXCD, xcd = wgid % NXCD, off = wgid / NXCD; wgid = (xcd < r ? xcd * (q + 1) : r * (q + 1) + (xcd - r) * q) + off; }
        const int nig = WGM * nN, gid = wgid / nig, fm = gid * WGM, gsz = (nM - fm) < WGM ? (nM - fm) : WGM;
        u.pm = fm + ((wgid % nig) % gsz); u.pn = (wgid % nig) / gsz; return true;
    }
    __device__ __forceinline__ void a_ready(const Unit&) const {}
    __device__ __forceinline__ void done(const Unit&) const {}
};
template <class Epi, class Sched, bool ALIGN_EPI = false, bool SP2 = false>
__device__ __forceinline__ void gemm_phase(PG8_LAS unsigned char* lds, const Gemm g, const Sched& S, const Epi& E) {
    const int tid = threadIdx.x, wid = __builtin_amdgcn_readfirstlane(tid >> 6), lane = tid & 63, wr = wid >> 2, wc = wid & 3, fr = lane & 15, fq = lane >> 4;
    const int K = g.K, nt = K / BK;
    unsigned voffA[2], voffB[2];
#pragma unroll
    for (int i = 0; i < 2; ++i) { int R, C; stage_rc(tid * 16 + i * 8192, R, C); const int Rb = Epi::PERM ? ((R & ~31) + perm32(R & 31)) : R;
        voffA[i] = (unsigned)(R * K + C) * 2u; voffB[i] = (unsigned)(Rb * K + C) * 2u; }
    const size_t kstep = (size_t)(BK * 2);
    const size_t hstep = (size_t)HALF * K * 2;
    const size_t tstep = 2 * hstep;
    const unsigned ldsw = (unsigned)wid * 1024u;
    const int aoff = lds_byte(wr * 64 + fr, fq * 8), boff = lds_byte(wc * 32 + fr, fq * 8);
#define PG8_SA(b, h) (((b) * 2 + (h)) * HTB)
#define PG8_SB(b, h) ((4 + (b) * 2 + (h)) * HTB)
#define PG8_STAGE(bufoff, gbase, voff) do { _Pragma("unroll") for (int _i = 0; _i < 2; ++_i) \
        __builtin_amdgcn_global_load_lds((const unsigned*)((const char*)(gbase) + (voff)[_i]), (PG8_LAS unsigned*)(lds + (bufoff) + ldsw + _i * 8192), 16, 0, 0); } while (0)
#define PG8_LDA(dst, b, h) do { _Pragma("unroll") for (int m = 0; m < 4; ++m) _Pragma("unroll") for (int k = 0; k < 2; ++k) dst[m][k] = *(const PG8_LAS bf16x8*)(lds + PG8_SA(b, h) + aoff + m * 2048 + k * 1024); } while (0)
#define PG8_LDB(dst, b, h) do { _Pragma("unroll") for (int n = 0; n < 2; ++n) _Pragma("unroll") for (int k = 0; k < 2; ++k) dst[n][k] = *(const PG8_LAS bf16x8*)(lds + PG8_SB(b, h) + boff + n * 2048 + k * 1024); } while (0)
#define PG8_MMA(ai, bj, At, Bt) do { __builtin_amdgcn_s_setprio(1); _Pragma("unroll") for (int m = 0; m < 4; ++m) _Pragma("unroll") for (int n = 0; n < 2; ++n) _Pragma("unroll") for (int k = 0; k < 2; ++k) \
        acc[ai][bj][m][n] = __builtin_amdgcn_mfma_f32_16x16x32_bf16(Bt[n][k], At[m][k], acc[ai][bj][m][n], 0, 0, 0); __builtin_amdgcn_s_setprio(0); } while (0)
#define PG8_WAIT_V(n) asm volatile("s_waitcnt vmcnt(" #n ")" ::: "memory")
#define PG8_WAIT_L(n) asm volatile("s_waitcnt lgkmcnt(" #n ")" ::: "memory")
#define PG8_BAR __builtin_amdgcn_s_barrier()
#define PG8_SCHED __builtin_amdgcn_sched_barrier(0)
    Unit cur, nxt; int ui = 0;
    if (!S.next(0, cur)) return;
    f32x4 acc[2][2][4][2];
#pragma unroll
    for (int a = 0; a < 2; ++a)
#pragma unroll
        for (int b = 0; b < 2; ++b)
#pragma unroll
            for (int m = 0; m < 4; ++m)
#pragma unroll
                for (int n = 0; n < 2; ++n) acc[a][b][m][n] = (f32x4){0.f, 0.f, 0.f, 0.f};
    bf16x8 At[4][2], B0[2][2], B1[2][2];
    const char* cA = (const char*)g.A + (size_t)cur.pm * tstep; const char* cB = (const char*)g.Bt + (size_t)cur.pn * tstep;
    S.a_ready(cur);
    if constexpr (SP2) {
        PG8_STAGE(PG8_SB(0, 0), cB, voffB); PG8_STAGE(PG8_SB(0, 1), cB + hstep, voffB); PG8_STAGE(PG8_SA(0, 0), cA, voffA); PG8_STAGE(PG8_SA(0, 1), cA + hstep, voffA);
        if (wr == 1) PG8_BAR;
        PG8_WAIT_V(2); PG8_BAR;
        PG8_STAGE(PG8_SB(1, 0), cB + kstep, voffB); PG8_STAGE(PG8_SA(1, 0), cA + kstep, voffA); PG8_STAGE(PG8_SB(1, 1), cB + hstep + kstep, voffB);
        PG8_WAIT_V(6); PG8_BAR;
    } else {
        PG8_STAGE(PG8_SB(0, 0), cB, voffB); PG8_STAGE(PG8_SA(0, 0), cA, voffA); PG8_STAGE(PG8_SB(0, 1), cB + hstep, voffB); PG8_STAGE(PG8_SA(0, 1), cA + hstep, voffA);
        if (wr == 1) PG8_BAR;
        PG8_WAIT_V(4); PG8_BAR;
        PG8_STAGE(PG8_SB(1, 0), cB + kstep, voffB); PG8_STAGE(PG8_SA(1, 0), cA + kstep, voffA); PG8_STAGE(PG8_SB(1, 1), cB + hstep + kstep, voffB);
        PG8_WAIT_V(6); PG8_BAR;
    }
    for (;;) {
        const bool has_next = S.next(ui + 1, nxt);
        const char* nA = has_next ? (const char*)g.A + (size_t)nxt.pm * tstep : cA; const char* nB = has_next ? (const char*)g.Bt + (size_t)nxt.pn * tstep : cB;
        for (int t = 0; t < nt; t += 2) {
            const bool last = (t == nt - 2);
            const char* a1 = cA + (size_t)(t + 1) * kstep;
            const char* a2 = last ? nA : cA + (size_t)(t + 2) * kstep; const char* b2 = last ? nB : cB + (size_t)(t + 2) * kstep;
            const char* a3 = a2 + kstep; const char* b3 = b2 + kstep;
            if (last && has_next) S.a_ready(nxt);
            if constexpr (SP2) {
            PG8_LDB(B0, 0, 0); PG8_LDB(B1, 0, 1); PG8_SCHED; PG8_LDA(At, 0, 0); PG8_STAGE(PG8_SA(1, 1), a1 + hstep, voffA);
            PG8_WAIT_V(8); PG8_WAIT_L(0); PG8_BAR; PG8_MMA(0, 0, At, B0); PG8_MMA(0, 1, At, B1); PG8_BAR; PG8_SCHED;
            PG8_LDA(At, 0, 1); PG8_STAGE(PG8_SB(0, 0), b2, voffB); PG8_STAGE(PG8_SB(0, 1), b2 + hstep, voffB); PG8_STAGE(PG8_SA(0, 0), a2, voffA);
            PG8_WAIT_V(8); PG8_WAIT_L(0); PG8_BAR; PG8_MMA(1, 0, At, B0); PG8_MMA(1, 1, At, B1); PG8_BAR; PG8_SCHED;
            PG8_LDB(B0, 1, 0); PG8_LDB(B1, 1, 1); PG8_SCHED; PG8_LDA(At, 1, 0); PG8_STAGE(PG8_SA(0, 1), a2 + hstep, voffA);
            PG8_WAIT_V(8); PG8_WAIT_L(0); PG8_BAR; PG8_MMA(0, 0, At, B0); PG8_MMA(0, 1, At, B1); PG8_BAR; PG8_SCHED;
            PG8_LDA(At, 1, 1); PG8_STAGE(PG8_SB(1, 0), b3, voffB); PG8_STAGE(PG8_SB(1, 1), b3 + hstep, voffB); PG8_STAGE(PG8_SA(1, 0), a3, voffA);
            PG8_WAIT_V(8); PG8_WAIT_L(0); PG8_BAR; PG8_MMA(1, 0, At, B0); PG8_MMA(1, 1, At, B1); PG8_BAR; PG8_SCHED;
            } else {
            PG8_LDB(B0, 0, 0); PG8_SCHED; PG8_LDA(At, 0, 0); PG8_STAGE(PG8_SA(1, 1), a1 + hstep, voffA);
            PG8_WAIT_L(8); PG8_BAR; PG8_WAIT_L(0); PG8_MMA(0, 0, At, B0); PG8_BAR; PG8_SCHED;
            PG8_LDB(B1, 0, 1); PG8_STAGE(PG8_SB(0, 0), b2, voffB);
            PG8_BAR; PG8_WAIT_L(0); PG8_MMA(0, 1, At, B1); PG8_BAR;
            PG8_LDA(At, 0, 1); PG8_STAGE(PG8_SA(0, 0), a2, voffA);
            PG8_BAR; PG8_WAIT_L(0); PG8_MMA(1, 0, At, B0); PG8_BAR; PG8_SCHED;
            PG8_STAGE(PG8_SB(0, 1), b2 + hstep, voffB);
            PG8_WAIT_V(6); PG8_BAR; PG8_MMA(1, 1, At, B1); PG8_BAR;
            PG8_LDB(B0, 1, 0); PG8_SCHED; PG8_LDA(At, 1, 0); PG8_STAGE(PG8_SA(0, 1), a2 + hstep, voffA);
            PG8_WAIT_L(8); PG8_BAR; PG8_WAIT_L(0); PG8_MMA(0, 0, At, B0); PG8_BAR; PG8_SCHED;
            PG8_LDB(B1, 1, 1); PG8_STAGE(PG8_SB(1, 0), b3, voffB);
            PG8_BAR; PG8_WAIT_L(0); PG8_MMA(0, 1, At, B1); PG8_BAR;
            PG8_LDA(At, 1, 1); PG8_STAGE(PG8_SA(1, 0), a3, voffA);
            PG8_BAR; PG8_WAIT_L(0); PG8_MMA(1, 0, At, B0); PG8_BAR; PG8_SCHED;
            PG8_STAGE(PG8_SB(1, 1), b3 + hstep, voffB);
            PG8_WAIT_V(6); PG8_BAR; PG8_MMA(1, 1, At, B1); PG8_BAR;
            }
        }
        if constexpr (ALIGN_EPI) { if (wr == 0) PG8_BAR; }
        if constexpr (!Epi::AFTER_DRAIN) { E(acc, cur, wr, wc, fr, fq); S.done(cur); }
        if (!has_next) break;
#pragma unroll
        for (int a = 0; a < 2; ++a)
#pragma unroll
            for (int b = 0; b < 2; ++b)
#pragma unroll
                for (int m = 0; m < 4; ++m)
#pragma unroll
                    for (int n = 0; n < 2; ++n) acc[a][b][m][n] = (f32x4){0.f, 0.f, 0.f, 0.f};
        cur = nxt; cA = nA; cB = nB; ++ui;
        if constexpr (ALIGN_EPI) { if (wr == 1) PG8_BAR; }
    }
    PG8_WAIT_V(0);
    if constexpr (!ALIGN_EPI) { if (wr == 0) PG8_BAR; }
    PG8_BAR;
    if constexpr (Epi::AFTER_DRAIN) { E.fused(acc, cur, wr, wc, fr, fq, lds, wid, lane); S.done(cur); }
#undef PG8_SA
#undef PG8_SB
#undef PG8_STAGE
#undef PG8_LDA
#undef PG8_LDB
#undef PG8_MMA
#undef PG8_WAIT_V
#undef PG8_WAIT_L
#undef PG8_BAR
#undef PG8_SCHED
}
}

template <class E1> struct EpiAdapt {
    static constexpr bool PERM = true, AFTER_DRAIN = false;
    E1 e;
    __device__ __forceinline__ void operator()(const pg8::f32x4 (&acc)[2][2][4][2], const pg8::Unit& u, int wr, int wc, int fr, int fq) const {
        E1 el = e; el.wash();
        const int row0 = u.pm * 256 + wr * 64 + fr, col0 = u.pn * 256 + wc * 32 + 8 * fq;
#define EA_BLK(ai, bj, m) { const pg8::f32x4 c0 = acc[ai][bj][m][0], c1 = acc[ai][bj][m][1]; \
        el.store8(row0 + (ai) * 128 + (m) * 16, col0 + (bj) * 128, (f32x4){c0[0], c0[1], c0[2], c0[3]}, (f32x4){c1[0], c1[1], c1[2], c1[3]}); }
#define EA_M(ai, bj) EA_BLK(ai, bj, 0) EA_BLK(ai, bj, 1) EA_BLK(ai, bj, 2) EA_BLK(ai, bj, 3)
        EA_M(0, 0) EA_M(0, 1) EA_M(1, 0) EA_M(1, 1)
#undef EA_M
#undef EA_BLK
    }
};
template <class E1>
__device__ __forceinline__ void gemm_pg8(unsigned char* lds, const bf16_t* A, const bf16_t* Bt, int M, int N, int K, const E1& e, int shift = 0) {
    pg8::Gemm g{A, Bt, M, N, K};
    pg8::StaticOrder S; S.init(M, N, (int)gridDim.x, (int)((blockIdx.x + shift) % gridDim.x));
    EpiAdapt<E1> E{e};
    pg8::gemm_phase<EpiAdapt<E1>, pg8::StaticOrder, true, true>((PG8_LAS unsigned char*)lds, g, S, E);
}

__device__ __forceinline__ void phase_lora(const Args& a) {
    const int lane = threadIdx.x & 63, gw = blockIdx.x * 8 + (threadIdx.x >> 6), nw = gridDim.x * 8;
    const int tk = lane & 15, kg = lane >> 4;
    const bf16_t* P0 = (const bf16_t*)((const unsigned char*)a.out + T_P0);
    const bf16_t* WU = (const bf16_t*)(a.ws + WS_WUP_T);
    const bf16_t* AU = (const bf16_t*)(a.ws + WS_AUP_T);
    _Float16* EA = (_Float16*)(a.ws + WS_EARR);
    _Float16* AA = (_Float16*)(a.ws + WS_AARR);
    const float* mu = a.in[16]; const float* w0 = a.in[17]; const float* a0 = a.in[19];
    auto do_unit = [&](const int u, const int nt0, const int nt1) __attribute__((always_inline)) {
        const int row = u * 16 + tk;
        const bool smp = row >= MP; const int t = smp ? ((row - MP) & 31) : (row & 4095); const int b = smp ? ((row - MP) >> 5) : (row >> 12);
        bf16x8 act[2][2];
#pragma unroll
        for (int which = 0; which < 2; ++which)
#pragma unroll
            for (int ks = 0; ks < 2; ++ks) {
                const int col = 4608 + which * 64 + ks * 32 + kg * 8;
                const u32x4 cur = *(const u32x4*)(P0 + (size_t)row * RWP + col);
                float pv[8];
                if (t > 0) { const u32x4 pr = *(const u32x4*)(P0 + (size_t)(row - 1) * RWP + col);
#pragma unroll
                    for (int e = 0; e < 4; ++e) { pv[2 * e] = bflo(pr[e]); pv[2 * e + 1] = bfhi(pr[e]); } }
                else if (smp) { const float* ss = a.in[4] + (size_t)b * RWP + col;
#pragma unroll
                    for (int e = 0; e < 8; ++e) pv[e] = ss[e]; }
                else {
#pragma unroll
                    for (int e = 0; e < 8; ++e) pv[e] = 0.f; }
                float xv[8];
#pragma unroll
                for (int e = 0; e < 8; ++e) { const float c = (e & 1) ? bfhi(cur[e >> 1]) : bflo(cur[e >> 1]); const float x = c + mu[col + e] * (pv[e] - c); xv[e] = which == 0 ? tanhf(x) : x; }
                u32x4 pk; pk.x = pk_bf16(xv[0], xv[1]); pk.y = pk_bf16(xv[2], xv[3]); pk.z = pk_bf16(xv[4], xv[5]); pk.w = pk_bf16(xv[6], xv[7]);
                act[which][ks] = __builtin_bit_cast(bf16x8, pk);
            }
        for (int nt = nt0; nt < nt1; ++nt) {
            const int n = nt * 16 + tk;
            const bf16x8 w0f = *(const bf16x8*)(WU + n * 64 + kg * 8), w1f = *(const bf16x8*)(WU + n * 64 + 32 + kg * 8);
            const bf16x8 a0f = *(const bf16x8*)(AU + n * 64 + kg * 8), a1f = *(const bf16x8*)(AU + n * 64 + 32 + kg * 8);
            f32x4 dw = {0.f, 0.f, 0.f, 0.f}, da = {0.f, 0.f, 0.f, 0.f};
            dw = __builtin_amdgcn_mfma_f32_16x16x32_bf16(w0f, act[0][0], dw, 0, 0, 0);
            dw = __builtin_amdgcn_mfma_f32_16x16x32_bf16(w1f, act[0][1], dw, 0, 0, 0);
            da = __builtin_amdgcn_mfma_f32_16x16x32_bf16(a0f, act[1][0], da, 0, 0, 0);
            da = __builtin_amdgcn_mfma_f32_16x16x32_bf16(a1f, act[1][1], da, 0, 0, 0);
            const int n0 = nt * 16 + kg * 4;
            const f32x4 w0v = *(const f32x4*)(w0 + n0), a0v = *(const f32x4*)(a0 + n0);
            h16x4 eo, ao;
#pragma unroll
            for (int j = 0; j < 4; ++j) {
                const float x = -(w0v[j] + dw[j]);
                const float sp = fmaxf(x, 0.f) + __logf(1.f + __expf(-fabsf(x)));
                eo[j] = (_Float16)__expf(-sp - 0.5f);
                ao[j] = (_Float16)(1.f / (1.f + __expf(-(a0v[j] + da[j]))));
            }
            *(h16x4*)(EA + (size_t)row * MIXW + n0) = eo;
            *(h16x4*)(AA + (size_t)row * MIXW + n0) = ao;
        }
    };
    const int n_units = MT / 16, n_main = (n_units / nw) * nw;
    for (int u = gw; u < n_main; u += nw) do_unit(u, 0, 96);
    for (int u = n_main + (int)blockIdx.x; u < n_units; u += (int)gridDim.x) { const int w = (int)(threadIdx.x >> 6); do_unit(u, 12 * w, 12 * w + 12); }
}

__device__ __forceinline__ void phase_scan(const Args& a, unsigned char* lds) {
    const int tid = threadIdx.x, wid = tid >> 6, lane = tid & 63;
    float* vec = (float*)lds;
    float* ybuf = (float*)(lds + 98304);
    float* bon = (float*)(lds + 114688);
    const bf16_t* P0 = (const bf16_t*)((const unsigned char*)a.out + T_P0);
    const _Float16* EA = (const _Float16*)(a.ws + WS_EARR);
    const _Float16* AA = (const _Float16*)(a.ws + WS_AARR);
    const bf16_t* GT = (const bf16_t*)(a.ws + WS_GATE);
    bf16_t* BRc = (bf16_t*)(a.ws + WS_BRANCH);
    const bool is_scan = wid < 4;
    const int hd = is_scan ? (wid >> 1) : ((wid - 4) >> 1), hw = (wid - 4) & 1;
    const int srow = (wid & 1) * 32 + (lane >> 1), cb = (lane & 1) * 32;
    const int item_stride = (int)gridDim.x > 192 ? ((int)blockIdx.x < 192 ? 384 : (int)gridDim.x - 192) : (int)gridDim.x;
    for (int item = blockIdx.x; item < 384; item += item_stride) {
        const bool smp = item >= 192; const int pair = smp ? item - 192 : item;
        const int T = smp ? 32 : 4096, nch = T / 16;
        const int bh = pair * 2 + hd, b = bh / 24, h = bh % 24;
        const int row0 = smp ? MP + b * 32 : b * 4096;
        const int hcol = h * 64 + lane;
        f32x2 S2[40];
#define HC4(k) ((f32x4){S2[2 * (k)].x, S2[2 * (k)].y, S2[2 * (k) + 1].x, S2[2 * (k) + 1].y})
#define PFU(pp, k) S2[16 + (pp) * 9 + (k)]
#pragma unroll
        for (int j = 0; j < 40; ++j) S2[j] = (f32x2){0.f, 0.f};
        const int hss = lane >> 4, hc4 = (lane & 15) * 4, hcol4 = h * 64 + hc4;
        if (is_scan) {
            if (smp) { const float* s0 = a.in[3] + ((size_t)bh * 64 + srow) * 64 + cb;
#pragma unroll
                for (int j = 0; j < 8; ++j) { const f32x4 q = *(const f32x4*)(s0 + 4 * j); S2[2 * j] = (f32x2){q[0], q[1]}; S2[2 * j + 1] = (f32x2){q[2], q[3]}; } }
        } else {
            const float* cp[8] = {a.in[16] + hcol4, a.in[16] + 1536 + hcol4, a.in[16] + 3072 + hcol4, a.in[21] + hcol4, a.in[22] + hcol4, a.in[23] + hcol4, a.in[24] + hcol4, a.in[25] + hcol4};
#pragma unroll
            for (int k = 0; k < 8; ++k) { const f32x4 q = *(const f32x4*)cp[k]; S2[2 * k] = (f32x2){q[0], q[1]}; S2[2 * k + 1] = (f32x2){q[2], q[3]}; }
        }
#define LOAD_PREP(c, cg, N) \
        _Pragma("unroll") for (int pp = 0; pp < 2; ++pp) { const int s = (2 * hw + pp) * 4 + hss; \
            if ((c) < nch) { const int t = (c) * 16 + s, row = row0 + t; const bf16_t* pr = P0 + (size_t)row * RWP + hcol4; \
                N[pp][0] = *(const u32x2*)pr; N[pp][1] = *(const u32x2*)(pr + 1536); N[pp][2] = *(const u32x2*)(pr + 3072); \
                if (t > 0) { N[pp][3] = *(const u32x2*)(pr - RWP); N[pp][4] = *(const u32x2*)(pr + 1536 - RWP); N[pp][5] = *(const u32x2*)(pr + 3072 - RWP); } \
                else if (smp) { const float* ss = a.in[4] + (size_t)b * RWP + hcol4; \
                    _Pragma("unroll") for (int q = 0; q < 3; ++q) { const f32x4 x = *(const f32x4*)(ss + 1536 * q); N[pp][3 + q] = (u32x2){pk_bf16(x[0], x[1]), pk_bf16(x[2], x[3])}; } } \
                else { N[pp][3] = (u32x2){0u, 0u}; N[pp][4] = (u32x2){0u, 0u}; N[pp][5] = (u32x2){0u, 0u}; } \
                N[pp][6] = *(const u32x2*)(EA + (size_t)row * MIXW + hcol4); N[pp][7] = *(const u32x2*)(AA + (size_t)row * MIXW + hcol4); } \
            if ((cg) >= 0 && (cg) < nch) N[pp][8] = *(const u32x2*)(GT + (size_t)(row0 + (cg) * 16 + s) * BR + hcol4); }
        if (!is_scan) {
            u32x2 N[2][9];
#pragma unroll
            for (int pp = 0; pp < 2; ++pp)
#pragma unroll
                for (int k = 0; k < 9; ++k) N[pp][k] = (u32x2){0u, 0u};
            LOAD_PREP(0, -1, N)
#pragma unroll
            for (int pp = 0; pp < 2; ++pp)
#pragma unroll
                for (int k = 0; k < 9; ++k) PFU(pp, k) = __builtin_bit_cast(f32x2, N[pp][k]);
        }
        for (int it = 0; it < nch + 2; ++it) {
            if (is_scan) {
                if (it >= 1 && it <= nch) {
                    const int c = it - 1, buf = c & 1;
                    const float* vb = vec + (size_t)((buf * 2 + hd) * 16) * 384 + cb;
                    float* yb = ybuf + ((buf * 2 + hd) * 16) * 64;
#define SB __builtin_amdgcn_sched_barrier(0)
#define LDG(G, c8) { const float* p_ = vs + (c8) * 8; G[0] = *(const f32x4*)(p_ + 192); G[1] = *(const f32x4*)(p_ + 196); G[2] = *(const f32x4*)(p_ + 320); G[3] = *(const f32x4*)(p_ + 324); \
                     G[4] = *(const f32x4*)(p_ + 64); G[5] = *(const f32x4*)(p_ + 68); G[6] = *(const f32x4*)(p_); G[7] = *(const f32x4*)(p_ + 4); }
#define CMP1(G, h, j) { f32x2 t0 = sa2 * (f32x2){G[2 + h][0], G[2 + h][1]} + v2 * (f32x2){G[4 + h][0], G[4 + h][1]}; \
                        f32x2 t1 = sa2 * (f32x2){G[2 + h][2], G[2 + h][3]} + v2 * (f32x2){G[4 + h][2], G[4 + h][3]}; \
                        S2[2 * (j)] = S2[2 * (j)] * (f32x2){G[h][0], G[h][1]} + t0; S2[2 * (j) + 1] = S2[2 * (j) + 1] * (f32x2){G[h][2], G[h][3]} + t1; \
                        y0 += S2[2 * (j)] * (f32x2){G[6 + h][0], G[6 + h][1]}; y1 += S2[2 * (j) + 1] * (f32x2){G[6 + h][2], G[6 + h][3]}; }
#define CMP(G, c8) { CMP1(G, 0, 2 * (c8)) CMP1(G, 1, 2 * (c8) + 1) }
                    f32x4 KA[8];
#pragma unroll
                    for (int j = 0; j < 8; ++j) KA[j] = *(const f32x4*)(vb + 256 + 4 * j);
#pragma nounroll
                    for (int s = 0; s < 16; ++s) {
                        const float* vs = vb + s * 384;
                        const float vi = vs[128 - cb + srow];
                        f32x4 G0[8], G1[8], G2[8];
                        LDG(G0, 0) SB;
                        LDG(G1, 1) SB;
                        f32x2 c0 = {0.f, 0.f}, c1 = {0.f, 0.f};
#pragma unroll
                        for (int j = 0; j < 8; ++j) { c0 += S2[2 * j] * (f32x2){KA[j][0], KA[j][1]}; c1 += S2[2 * j + 1] * (f32x2){KA[j][2], KA[j][3]}; }
                        float cs = (c0.x + c0.y) + (c1.x + c1.y);
                        cs += dpp_f(cs, 0);
                        const float sa = -cs;
                        const f32x2 sa2 = {sa, sa}, v2 = {vi, vi};
                        f32x2 y0 = {0.f, 0.f}, y1 = {0.f, 0.f};
                        SB; LDG(G2, 2) SB; CMP(G0, 0) SB;
                        LDG(G0, 3) SB; CMP(G1, 1) SB;
                        CMP(G2, 2) SB;
#pragma unroll
                        for (int j = 0; j < 8; ++j) KA[j] = *(const f32x4*)(vs + 384 + 256 + 4 * j);
                        SB; CMP(G0, 3) SB;
                        float ys = (y0.x + y0.y) + (y1.x + y1.y);
                        ys += dpp_f(ys, 0);
                        if ((lane & 1) == 0) yb[s * 64 + srow] = ys;
                    }
#undef CMP
#undef CMP1
#undef LDG
#undef SB
                }
            } else {
                u32x2 N[2][9];
#pragma unroll
                for (int pp = 0; pp < 2; ++pp)
#pragma unroll
                    for (int k = 0; k < 9; ++k) N[pp][k] = (u32x2){0u, 0u};
                LOAD_PREP(it + 1, it - 1, N)
                const f32x4 mu_r = HC4(0), mu_k = HC4(1), mu_v = HC4(2), kkw = HC4(3), kaw = HC4(4), rkw = HC4(5), lnw = HC4(6), lnb = HC4(7);
#define UNPK(w) ((f32x4){bflo((w).x), bfhi((w).x), bflo((w).y), bfhi((w).y)})
#define ROWSUM16(v) { v += dpp_f(v, 0); v += dpp_f(v, 1); v += dpp_f(v, 2); v += dpp_f(v, 3); }
                if (it >= 2) {
                    const int c = it - 2, buf = c & 1;
#pragma unroll
                    for (int pp = 0; pp < 2; ++pp) { const int s = (2 * hw + pp) * 4 + hss;
                        const int row = row0 + c * 16 + s;
                        const f32x4 y = *(const f32x4*)(ybuf + ((buf * 2 + hd) * 16 + s) * 64 + hc4);
                        float sm = (y[0] + y[1]) + (y[2] + y[3]); ROWSUM16(sm)
                        const float mean = sm * (1.f / 64.f);
                        const f32x4 d = y - mean;
                        float sq = (d[0] * d[0] + d[1] * d[1]) + (d[2] * d[2] + d[3] * d[3]); ROWSUM16(sq)
                        const float rs = rsqrtf(sq * (1.f / 64.f) + 64e-5f);
                        const f32x4 vv = *(const f32x4*)(vec + (size_t)((buf * 2 + hd) * 16 + s) * 384 + 128 + hc4);
                        const float bo = bon[(buf * 2 + hd) * 16 + s];
                        const f32x4 g = UNPK(__builtin_bit_cast(u32x2, PFU(pp, 8)));
                        const f32x4 o = (d * rs * lnw + lnb + bo * vv) * g;
                        *(u32x2*)(BRc + (size_t)row * BR + hcol4) = (u32x2){pk_bf16(o[0], o[1]), pk_bf16(o[2], o[3])};
                    }
                }
                if (it < nch) {
                    const int c = it, buf = c & 1;
#pragma unroll
                    for (int pp = 0; pp < 2; ++pp) { const int s = (2 * hw + pp) * 4 + hss;
                        const f32x4 rc = UNPK(__builtin_bit_cast(u32x2, PFU(pp, 0))), kc = UNPK(__builtin_bit_cast(u32x2, PFU(pp, 1))), vc = UNPK(__builtin_bit_cast(u32x2, PFU(pp, 2)));
                        const f32x4 rp = UNPK(__builtin_bit_cast(u32x2, PFU(pp, 3))), kp = UNPK(__builtin_bit_cast(u32x2, PFU(pp, 4))), vp = UNPK(__builtin_bit_cast(u32x2, PFU(pp, 5)));
                        const h16x4 eh = __builtin_bit_cast(h16x4, PFU(pp, 6)), ah = __builtin_bit_cast(h16x4, PFU(pp, 7));
                        const f32x4 r = rc + mu_r * (rp - rc), k = kc + mu_k * (kp - kc), v = vc + mu_v * (vp - vc);
                        const f32x4 aa = {(float)ah[0], (float)ah[1], (float)ah[2], (float)ah[3]};
                        const f32x4 dec = {__expf(-(float)eh[0]), __expf(-(float)eh[1]), __expf(-(float)eh[2]), __expf(-(float)eh[3])};
                        const f32x4 kkr = k * kkw;
                        float n2 = (kkr[0] * kkr[0] + kkr[1] * kkr[1]) + (kkr[2] * kkr[2] + kkr[3] * kkr[3]); ROWSUM16(n2)
                        const f32x4 kk = kkr * rsqrtf(fmaxf(n2, 1e-24f));
                        const f32x4 kpr = k * (1.f + (aa - 1.f) * kaw);
                        const f32x4 bbv = kk * aa;
                        const f32x4 bt = r * kpr * rkw;
                        float bonus = (bt[0] + bt[1]) + (bt[2] + bt[3]); ROWSUM16(bonus)
                        float* vs = vec + (size_t)((buf * 2 + hd) * 16 + s) * 384 + hc4;
                        *(f32x4*)vs = r; *(f32x4*)(vs + 64) = kpr; *(f32x4*)(vs + 128) = v; *(f32x4*)(vs + 192) = dec; *(f32x4*)(vs + 256) = kk; *(f32x4*)(vs + 320) = bbv;
                        if ((lane & 15) == 0) bon[(buf * 2 + hd) * 16 + s] = bonus;
                    }
                }
#undef UNPK
#undef ROWSUM16
#pragma unroll
                for (int pp = 0; pp < 2; ++pp)
#pragma unroll
                    for (int k = 0; k < 9; ++k) PFU(pp, k) = __builtin_bit_cast(f32x2, N[pp][k]);
            }
            __syncthreads();
        }
#undef LOAD_PREP
        if (is_scan) {
            float* so = a.out + (smp ? O_SS : O_PS) + ((size_t)bh * 64 + srow) * 64 + cb;
#pragma unroll
            for (int j = 0; j < 8; ++j) *(f32x4*)(so + 4 * j) = (f32x4){S2[2 * j].x, S2[2 * j].y, S2[2 * j + 1].x, S2[2 * j + 1].y};
        }
#undef PFU
#undef HC4
    }
    __builtin_amdgcn_s_setprio(0);
}

struct AUnit {
    int qrow0, nqw, qcol, ntiles, lim0, causal, last_valid, ld;
    const bf16_t* kb; const bf16_t* vb;
};
constexpr int A_KRS = 272, A_VRS = 320, A_KT = 64 * A_KRS, A_VT = 64 * A_VRS, A_BUF = A_KT + A_VT;

__device__ __forceinline__ void attn_load1(const bf16_t* __restrict__ src, int ld, int t, u32x4 (&r)[2]) {
    const int tid = threadIdx.x;
#pragma unroll
    for (int i = 0; i < 2; ++i) {
        const int c = tid + NTHR * i, key = c >> 4, ch = c & 15;
        r[i] = *(const u32x4*)(src + (size_t)(t * 64 + key) * ld + ch * 8);
    }
}
__device__ __forceinline__ void attn_store1(unsigned char* buf, int rs, const u32x4 (&r)[2]) {
    const int tid = threadIdx.x;
#pragma unroll
    for (int i = 0; i < 2; ++i) {
        const int c = tid + NTHR * i, key = c >> 4, ch = c & 15;
        *(u32x4*)(buf + key * rs + ch * 16) = r[i];
    }
}

template <int NS, int SI>
__device__ __forceinline__ void attn_stream(const unsigned char* kbase, const unsigned char* vbase, const unsigned char* q_rd, bool mask_tail, int last_valid, int hh, float sc,
                                            f32x16 (&O)[4], float& mrun, float& lrun) {
    f32x16 S0, S1;
#pragma unroll
    for (int r = 0; r < 16; ++r) { S0[r] = 0.f; S1[r] = 0.f; }
    __builtin_amdgcn_s_setprio(1);
#pragma unroll
    for (int k2 = 0; k2 < 8 / NS; ++k2) {
        const int ks = SI * (8 / NS) + k2;
        if (k2 == 2 || k2 == 4 || k2 == 6) __builtin_amdgcn_sched_barrier(0);
        const bf16x8 qf = *(const bf16x8*)(q_rd + ks * 32);
        const bf16x8 k0 = *(const bf16x8*)(kbase + ks * 32);
        const bf16x8 k1 = *(const bf16x8*)(kbase + 32 * A_KRS + ks * 32);
        S0 = __builtin_amdgcn_mfma_f32_32x32x16_bf16(k0, qf, S0, 0, 0, 0);
        S1 = __builtin_amdgcn_mfma_f32_32x32x16_bf16(k1, qf, S1, 0, 0, 0);
    }
    __builtin_amdgcn_s_setprio(0);
    __builtin_amdgcn_sched_barrier(0);
    if (mask_tail) {
        const int thr = last_valid - 4 * hh;
#pragma unroll
        for (int r = 0; r < 16; ++r) { if ((r & 3) + 8 * (r >> 2) >= thr) S0[r] = -1e30f; if (32 + (r & 3) + 8 * (r >> 2) >= thr) S1[r] = -1e30f; }
    }
    float mx = __builtin_amdgcn_fmed3f(S0[0], S1[0], __builtin_inff());
#pragma unroll
    for (int r = 1; r < 16; ++r) { mx = __builtin_amdgcn_fmed3f(mx, S0[r], __builtin_inff()); mx = __builtin_amdgcn_fmed3f(mx, S1[r], __builtin_inff()); }
    mx = fmaxf(mx, __shfl_xor(mx, 32));
    const float mn = fmaxf(mrun, mx * sc);
    const float alpha = __builtin_amdgcn_exp2f(mrun - mn);
    mrun = mn;
    f32x2 ls2 = {0.f, 0.f};
    const f32x2 sc2 = {sc, sc}, mn2 = {mn, mn};
#pragma unroll
    for (int r = 0; r < 16; r += 2) {
        const f32x2 t0 = (f32x2){S0[r], S0[r + 1]} * sc2 - mn2, t1 = (f32x2){S1[r], S1[r + 1]} * sc2 - mn2;
        const f32x2 p0 = {__builtin_amdgcn_exp2f(t0.x), __builtin_amdgcn_exp2f(t0.y)}, p1 = {__builtin_amdgcn_exp2f(t1.x), __builtin_amdgcn_exp2f(t1.y)};
        S0[r] = p0.x; S0[r + 1] = p0.y; S1[r] = p1.x; S1[r + 1] = p1.y; ls2 += p0 + p1;
    }
    lrun = lrun * alpha + (ls2.x + ls2.y);
    if (__any(alpha != 1.0f)) {
#pragma unroll
        for (int d = 0; d < 4; ++d) O[d] = O[d] * alpha;
    }
#define PV_GROUP(SX, kb, s2) { \
        u32x4 pp; pp.x = pk_bf16(SX[8 * (s2) + 0], SX[8 * (s2) + 1]); pp.y = pk_bf16(SX[8 * (s2) + 2], SX[8 * (s2) + 3]); \
        pp.z = pk_bf16(SX[8 * (s2) + 4], SX[8 * (s2) + 5]); pp.w = pk_bf16(SX[8 * (s2) + 6], SX[8 * (s2) + 7]); \
        const bf16x8 pf = __builtin_bit_cast(bf16x8, pp); \
        const unsigned char* vb0 = vbase + ((kb) * 32 + (s2) * 16) * A_VRS; \
        _Pragma("unroll") for (int d = 0; d < 4; ++d) { \
            if (d == 2) __builtin_amdgcn_sched_barrier(0); \
            const s16x4 lo = __builtin_amdgcn_ds_read_tr16_b64_v4i16((LAS s16x4*)(vb0 + d * 64)); \
            const s16x4 hi = __builtin_amdgcn_ds_read_tr16_b64_v4i16((LAS s16x4*)(vb0 + 8 * A_VRS + d * 64)); \
            const bf16x8 vf = {lo[0], lo[1], lo[2], lo[3], hi[0], hi[1], hi[2], hi[3]}; \
            O[d] = __builtin_amdgcn_mfma_f32_32x32x16_bf16(vf, pf, O[d], 0, 0, 0); } \
        __builtin_amdgcn_sched_barrier(0); }
    __builtin_amdgcn_sched_barrier(0);
    __builtin_amdgcn_s_setprio(1);
    PV_GROUP(S0, 0, 0) PV_GROUP(S0, 0, 1) PV_GROUP(S1, 1, 0) PV_GROUP(S1, 1, 1)
    __builtin_amdgcn_s_setprio(0);
#undef PV_GROUP
}

template <int NS>
__device__ __forceinline__ void attn_unit(const AUnit& u, unsigned char* lds, const bf16_t* __restrict__ GT, bf16_t* BRc, float sc, float lam, const float* __restrict__ subln) {
    const int tid = threadIdx.x, wid = tid >> 6, lane = tid & 63, l31 = lane & 31, hh = lane >> 5;
    const bool active = wid < u.nqw;
    const int limit = u.causal ? u.lim0 + (wid >> 1) : u.ntiles;
    const int qrow = u.qrow0 + wid * 32 + l31;
    unsigned char* qs = lds + 2 * A_BUF + wid * (32 * A_KRS);
    if (active) {
        const bf16_t* qp = BRc + (size_t)qrow * BR + u.qcol + hh * 64;
#pragma unroll
        for (int i = 0; i < 8; ++i) *(u32x4*)(qs + l31 * A_KRS + hh * 128 + i * 16) = *(const u32x4*)(qp + i * 8);
    }
    const unsigned char* q_rd = qs + l31 * A_KRS + hh * 16;
    f32x16 O0[4], O1[4];
    float m0 = -1e30f, m1 = -1e30f, l0r = 0.f, l1r = 0.f;
#pragma unroll
    for (int d = 0; d < 4; ++d)
#pragma unroll
        for (int r = 0; r < 16; ++r) { O0[d][r] = 0.f; O1[d][r] = 0.f; }
    u32x4 rk[2], rv[2];
    attn_load1(u.kb, u.ld, 0, rk); attn_load1(u.vb, u.ld, 0, rv);
    attn_store1(lds, A_KRS, rk); attn_store1(lds + A_KT, A_VRS, rv);
    __syncthreads();
    const int trq = (lane & 15) >> 2, trp = lane & 3, trblk = (lane >> 4) & 1;
    const int v_rd = A_KT + (4 * hh + trq) * A_VRS + (16 * trblk + 4 * trp) * 2;
    const int k_rd = l31 * A_KRS + hh * 16;
    for (int t = 0; t < u.ntiles; ++t) {
        const int cur = t & 1;
        const bool more = t + 1 < u.ntiles;
        const bool work = active && t < limit;
        const unsigned char* kbase = lds + cur * A_BUF + k_rd;
        const unsigned char* vbase = lds + cur * A_BUF + v_rd;
        const bool mask_tail = (t == u.ntiles - 1) && (u.last_valid < 64);
        unsigned char* nb = lds + (cur ^ 1) * A_BUF;
        if (NS == 2) {
            if (more) attn_load1(u.kb, u.ld, t + 1, rk);
            if (work) attn_stream<NS, 0>(kbase, vbase, q_rd, mask_tail, u.last_valid, hh, sc, O0, m0, l0r);
            if (more) { attn_store1(nb, A_KRS, rk); attn_load1(u.vb, u.ld, t + 1, rk); }
            if (work) attn_stream<NS, 1>(kbase, vbase, q_rd, mask_tail, u.last_valid, hh, sc, O1, m1, l1r);
            if (more) attn_store1(nb + A_KT, A_VRS, rk);
        } else {
            if (more) { attn_load1(u.kb, u.ld, t + 1, rk); attn_load1(u.vb, u.ld, t + 1, rv); }
            if (work) attn_stream<NS, 0>(kbase, vbase, q_rd, mask_tail, u.last_valid, hh, sc, O0, m0, l0r);
            if (more) { attn_store1(nb, A_KRS, rk); attn_store1(nb + A_KT, A_VRS, rv); }
        }
        __syncthreads();
    }
    if (active) {
        float l0 = l0r + __shfl_xor(l0r, 32);
        const float i0 = 1.f / l0;
        float post = 1.f;
        if (NS == 2) {
            float l1 = l1r + __shfl_xor(l1r, 32);
            const float i1 = lam / l1;
            float ss = 0.f;
#pragma unroll
            for (int d = 0; d < 4; ++d)
#pragma unroll
                for (int r = 0; r < 16; ++r) { const float o = O0[d][r] * i0 - O1[d][r] * i1; O0[d][r] = o; ss += o * o; }
            ss += __shfl_xor(ss, 32);
            post = rsqrtf(ss * (1.f / 128.f) + 1e-6f) * (1.0f - 0.35550907f);
        } else {
#pragma unroll
            for (int d = 0; d < 4; ++d) O0[d] = O0[d] * i0;
        }
        const size_t rb = (size_t)qrow * BR + u.qcol;
        __builtin_amdgcn_sched_barrier(0);
#pragma unroll
        for (int d = 0; d < 4; ++d)
#pragma unroll
            for (int rq = 0; rq < 4; ++rq) {
                if ((rq & 1) == 0) __builtin_amdgcn_sched_barrier(0);
                const int dv0 = d * 32 + 8 * rq + 4 * hh;
                const u32x2 g = *(const u32x2*)(GT + rb + dv0);
                f32x4 sv = {1.f, 1.f, 1.f, 1.f};
                if (NS == 2) sv = *(const f32x4*)(subln + dv0);
                const float o0 = O0[d][4 * rq + 0] * post * sv[0] * bflo(g.x), o1 = O0[d][4 * rq + 1] * post * sv[1] * bfhi(g.x);
                const float o2 = O0[d][4 * rq + 2] * post * sv[2] * bflo(g.y), o3 = O0[d][4 * rq + 3] * post * sv[3] * bfhi(g.y);
                u32x2 w; w.x = pk_bf16(o0, o1); w.y = pk_bf16(o2, o3);
                *(u32x2*)(BRc + rb + dv0) = w;
            }
    }
    __syncthreads();
}

__device__ __forceinline__ void mem_attn_units(const Args& a, unsigned char* lds, int li, int first, int stride) {
    const bf16_t* GT = (const bf16_t*)(a.ws + WS_GATE);
    bf16_t* BRc = (bf16_t*)(a.ws + WS_BRANCH);
    const bf16_t* MK = (const bf16_t*)(a.ws + WS_MKB) + (size_t)li * 8192 * 512;
    const bf16_t* MV = (const bf16_t*)(a.ws + WS_MVB) + (size_t)li * 8192 * 512;
    const float sc = 0.08838834764831845f * 1.4426950408889634f;
    for (int j = first; j < 1024 + 64; j += stride) {
        AUnit u; u.causal = 0; u.lim0 = 0; u.ntiles = 4; u.last_valid = 64; u.ld = 512;
        int h, mrow;
        if (j < 1024) { const int pm = j >> 2; h = j & 3; u.qrow0 = pm * 256; u.nqw = 8; mrow = (pm >> 4) * 256; }
        else { const int q = j - 1024, b = q >> 2; h = q & 3; u.qrow0 = MP + b * 32; u.nqw = 1; mrow = 4096 + b * 256; }
        u.qcol = 1536 + h * 128;
        u.kb = MK + (size_t)mrow * 512 + h * 128; u.vb = MV + (size_t)mrow * 512 + h * 128;
        attn_unit<1>(u, lds, GT, BRc, sc, 0.f, nullptr);
    }
}

__device__ __forceinline__ void diff_attn_units(const Args& a, unsigned char* lds) {
    const bf16_t* GT = (const bf16_t*)(a.ws + WS_GATE);
    bf16_t* BRc = (bf16_t*)(a.ws + WS_BRANCH);
    const bf16_t* KB = (const bf16_t*)(a.ws + WS_KB);
    const bf16_t* VB = (const bf16_t*)(a.ws + WS_VB);
    const bf16_t* SK = (const bf16_t*)((const unsigned char*)a.out + T_SK);
    const bf16_t* SV = (const bf16_t*)((const unsigned char*)a.out + T_SV);
    float s1 = 0.f, s2 = 0.f;
    for (int i = 0; i < 64; ++i) { s1 += a.in[27][i] * a.in[28][i]; s2 += a.in[29][i] * a.in[30][i]; }
    const float lam = __expf(s1) - __expf(s2) + 0.35550907f;
    const float sc = 0.125f * 1.4426950408889634f;
    const int G = (int)gridDim.x, bI = (int)blockIdx.x;
    const int n_own = (3072 + G - 1) / G;
    const int n_smp = (192 - (G - 1 - bI) + G - 1) / G;
    for (int it = 0; it < n_own + (n_smp > 0 ? n_smp : 0); ++it) {
        const int j = it < n_own ? it * G + ((it & 1) ? G - 1 - bI : bI) : 3072 + (G - 1 - bI) + (it - n_own) * G;
        if (it < n_own && j >= 3072) continue;
        AUnit u; u.ld = MIXW;
        if (j < 3072) {
            const int qt = 15 - j / 192, bh = j % 192, b = bh / 12, h = bh % 12;
            u.qrow0 = b * 4096 + qt * 256; u.nqw = 8; u.qcol = h * 128; u.ntiles = qt * 4 + 4; u.lim0 = qt * 4 + 1; u.causal = 1; u.last_valid = 64;
            u.kb = KB + (size_t)(b * 4096) * MIXW + h * 128; u.vb = VB + (size_t)(b * 4096) * MIXW + h * 128;
        } else {
            const int bh = j - 3072, b = bh / 12, h = bh % 12;
            u.qrow0 = MP + b * 32; u.nqw = 1; u.qcol = h * 128; u.ntiles = 17; u.lim0 = 0; u.causal = 0; u.last_valid = 32;
            u.kb = SK + (size_t)(b * 1088) * MIXW + h * 128; u.vb = SV + (size_t)(b * 1088) * MIXW + h * 128;
        }
        attn_unit<2>(u, lds, GT, BRc, sc, lam, a.in[31]);
    }
}

__device__ __forceinline__ void phase_sample_kv(const Args& a) {
    const size_t ngr = (size_t)16 * 1088 * 192;
    const bf16_t* KB = (const bf16_t*)(a.ws + WS_KB);
    const bf16_t* VB = (const bf16_t*)(a.ws + WS_VB);
    for (size_t i = (size_t)blockIdx.x * NTHR + threadIdx.x; i < 2 * ngr; i += (size_t)gridDim.x * NTHR) {
        const int kv = i >= ngr; const size_t g = kv ? i - ngr : i;
        const int cg8 = (int)(g % 192); const int key = (int)((g / 192) % 1088); const int b = (int)(g / (192 * 1088));
        u32x4 o = {0u, 0u, 0u, 0u};
        if (key < 1024) {
            const float* s = (kv ? a.in[6] : a.in[5]) + ((size_t)b * 1024 + key) * MIXW + cg8 * 8;
            const f32x4 x0 = *(const f32x4*)s, x1 = *(const f32x4*)(s + 4);
            o = (u32x4){pk_bf16(x0[0], x0[1]), pk_bf16(x0[2], x0[3]), pk_bf16(x1[0], x1[1]), pk_bf16(x1[2], x1[3])};
        } else if (key < 1056) {
            o = *(const u32x4*)((kv ? VB : KB) + (size_t)(MP + b * 32 + key - 1024) * MIXW + cg8 * 8);
        }
        *(u32x4*)((bf16_t*)((unsigned char*)a.out + (kv ? T_SV : T_SK)) + ((size_t)b * 1088 + key) * MIXW + cg8 * 8) = o;
    }
}

__device__ __forceinline__ Args load_args() {
    typedef __attribute__((address_space(4))) const Args* KP;
    KP kp = (KP)__builtin_amdgcn_kernarg_segment_ptr();
    asm volatile("" : "+s"(kp));
    Args r;
#pragma unroll
    for (int i = 0; i < 32; ++i) r.in[i] = kp->in[i];
    r.out = kp->out; r.ws = kp->ws; r.ph_lo = kp->ph_lo; r.ph_hi = kp->ph_hi;
    return r;
}

__global__ void __launch_bounds__(NTHR) mega(Args a) {
    extern __shared__ __attribute__((aligned(16))) unsigned char lds[];
    const int wid = threadIdx.x >> 6, lane = threadIdx.x & 63;
#define PH(n) if ((n) > a.ph_lo && (n) < a.ph_hi) cg::this_grid().sync(); if ((n) >= a.ph_lo && (n) < a.ph_hi)
    PH(0) { const Args A = load_args(); unsigned char* ws = A.ws; unsigned char* ob = (unsigned char*)A.out; (void)ws; (void)ob; phase_prep(A, lds); }
    PH(1) { const Args A = load_args(); unsigned char* ws = A.ws; unsigned char* ob = (unsigned char*)A.out; (void)ws; (void)ob;
            for (int li = 0; li < 2; ++li) {
                EpiMem E{A.out, ws, li};
                gemm_pg8(lds, (const bf16_t*)(ws + WS_HM) + (size_t)li * 4096 * 1024, (const bf16_t*)(ws + WS_WMEM_T) + (size_t)li * 1024 * 1024, 4096, 1024, 1024, E, li ? 128 : 192);
            }
            EpiIn0 E{A.out, ws};
            gemm_pg8(lds, (const bf16_t*)(ob + T_HB), (const bf16_t*)(ws + WS_RWIN_T), MT, RWIN_PAD, 1024, E);
        }
    PH(2) { const Args A = load_args(); unsigned char* ws = A.ws; unsigned char* ob = (unsigned char*)A.out; (void)ws; (void)ob; phase_lora(A); }
    PH(3) { const Args A = load_args(); unsigned char* ws = A.ws; unsigned char* ob = (unsigned char*)A.out; (void)ws; (void)ob; if (blockIdx.x >= 192) mem_attn_units(A, lds, 0, blockIdx.x - 192, gridDim.x - 192); phase_scan(A, lds); }
    PH(4) { const Args A = load_args(); unsigned char* ws = A.ws; unsigned char* ob = (unsigned char*)A.out; (void)ws; (void)ob; EpiOut0 E{A.out};
            gemm_pg8(lds, (const bf16_t*)(ws + WS_BRANCH), (const bf16_t*)(ws + WS_WOUT_T), MT, 1024, 2048, E); }
    PH(5) { const Args A = load_args(); unsigned char* ws = A.ws; unsigned char* ob = (unsigned char*)A.out; (void)ws; (void)ob;
            const int gw = blockIdx.x * 8 + wid, nw = gridDim.x * 8;
            for (int r = gw; r < MT; r += nw)
                norm_row_bf16(xrow(A, r), (const bf16_t*)(ob + T_D0) + (size_t)r * DM, A.in[9] + DM, (bf16_t*)(ob + T_HB) + (size_t)r * DM, nullptr, nullptr, lane);
        }
    PH(6) { const Args A = load_args(); unsigned char* ws = A.ws; unsigned char* ob = (unsigned char*)A.out; (void)ws; (void)ob; EpiIn1 E{A.out, ws};
            gemm_pg8(lds, (const bf16_t*)(ob + T_HB), (const bf16_t*)(ws + WS_DFIN_T), MT, DFIN, 1024, E); }
    PH(7) { const Args A = load_args(); unsigned char* ws = A.ws; unsigned char* ob = (unsigned char*)A.out; (void)ws; (void)ob; phase_sample_kv(A); }
    PH(8) { const Args A = load_args(); unsigned char* ws = A.ws; unsigned char* ob = (unsigned char*)A.out; (void)ws; (void)ob; diff_attn_units(A, lds); mem_attn_units(A, lds, 1, blockIdx.x, gridDim.x); }
    PH(9) { const Args A = load_args(); unsigned char* ws = A.ws; unsigned char* ob = (unsigned char*)A.out; (void)ws; (void)ob; EpiOut1 E{A.in[0], A.in[2], A.out, ws};
            gemm_pg8(lds, (const bf16_t*)(ws + WS_BRANCH), (const bf16_t*)(ws + WS_WOUT_T) + (size_t)1024 * 2048, MT, 1024, 2048, E); }
    PH(10) { const Args A = load_args(); unsigned char* ws = A.ws; unsigned char* ob = (unsigned char*)A.out; (void)ws; (void)ob;
            const int gw = blockIdx.x * 8 + wid, nw = gridDim.x * 8;
            const float* X2 = (const float*)(ws + WS_X2); const float* fw = A.in[14];
            for (int r = gw; r < MT; r += nw) {
                const float* x = X2 + (size_t)r * DM;
                float* o = r < MP ? A.out + O_Y + (size_t)r * DM : A.out + O_YS + (size_t)(r - MP) * DM;
                f32x4 v[4]; float ss = 0.f;
#pragma unroll
                for (int i = 0; i < 4; ++i) { v[i] = *(const f32x4*)(x + i * 256 + lane * 4); ss += v[i][0] * v[i][0] + v[i][1] * v[i][1] + v[i][2] * v[i][2] + v[i][3] * v[i][3]; }
                ss = wave_sum(ss);
                const float rs = rsqrtf(ss * (1.0f / 1024.0f) + 1e-6f);
#pragma unroll
                for (int i = 0; i < 4; ++i) { const f32x4 g = *(const f32x4*)(fw + i * 256 + lane * 4); *(f32x4*)(o + i * 256 + lane * 4) = v[i] * rs * g; }
            }
        }
}

constexpr int N_PHASES = 11;

extern "C" void kernel_launch(void* const* d_in, const int* in_sizes, int n_in, void* d_out, int out_size, void* d_ws, size_t ws_size, hipStream_t stream) {
    static int grid = 0;
    if (grid == 0) {
        int dev = 0, cus = 0, per_cu = 0;
        hipGetDevice(&dev);
        hipDeviceGetAttribute(&cus, hipDeviceAttributeMultiprocessorCount, dev);
        if (hipFuncSetAttribute((const void*)mega, hipFuncAttributeMaxDynamicSharedMemorySize, LDS_BYTES) != hipSuccess) { fprintf(stderr, "hipFuncSetAttribute failed\n"); }
        if (hipOccupancyMaxActiveBlocksPerMultiprocessor(&per_cu, (const void*)mega, NTHR, LDS_BYTES) != hipSuccess || per_cu < 1) { fprintf(stderr, "occupancy query: %d\n", per_cu); per_cu = 1; }
        (void)hipGetLastError();
        grid = cus * 1;
        if (n_in != 32 || ws_size < WS_END) fprintf(stderr, "kernel_launch: unexpected n_in %d / ws %zu (need %zu)\n", n_in, ws_size, (size_t)WS_END);
    }
    Args a{};
    for (int i = 0; i < 32; ++i) a.in[i] = (const float*)d_in[i];
    a.out = (float*)d_out; a.ws = (unsigned char*)d_ws;
#ifdef MULTI_LAUNCH
    for (int ph = 0; ph < N_PHASES; ++ph) { a.ph_lo = ph; a.ph_hi = ph + 1; hipLaunchKernelGGL(mega, dim3(grid), dim3(NTHR), LDS_BYTES, stream, a); }
#else
    a.ph_lo = 0; a.ph_hi = N_PHASES;
    void* args[] = {&a};
    hipError_t e = hipLaunchCooperativeKernel((const void*)mega, dim3(grid), dim3(NTHR), args, LDS_BYTES, stream);
    if (e != hipSuccess) fprintf(stderr, "cooperative launch failed: %s (grid %d)\n", hipGetErrorString(e), grid);
#endif
}
```

```cpp
#include <hip/hip_runtime.h>
#include <hip/hip_cooperative_groups.h>
#include <cstdio>
#include <cstdint>
namespace cg = cooperative_groups;

typedef unsigned short bf16_t;
typedef short bf16x8 __attribute__((ext_vector_type(8)));
typedef short s16x4 __attribute__((ext_vector_type(4)));
typedef float f32x16 __attribute__((ext_vector_type(16)));
typedef float f32x4 __attribute__((ext_vector_type(4)));
typedef float f32x2 __attribute__((ext_vector_type(2)));
typedef unsigned u32x4 __attribute__((ext_vector_type(4)));
typedef unsigned u32x2 __attribute__((ext_vector_type(2)));
typedef _Float16 h16x4 __attribute__((ext_vector_type(4)));
#define LAS __attribute__((address_space(3)))

constexpr int DM = 1024, MP = 65536, MS = 512, MT = MP + MS  ;
constexpr int RWP = 4736, RWIN = 7296, RWIN_PAD = 7424, DFIN = 7168, MIXW = 1536, BR = 2048;
constexpr int NTHR = 512;
constexpr int LDS_BYTES = 147456;

constexpr size_t O_Y = 0, O_YS = 67108864, O_PS = O_YS + 524288, O_PSH = O_PS + 1572864, O_PK = O_PSH + 75776,
                 O_PV = O_PK + 100663296, O_PMK = O_PV + 100663296, O_PMV = O_PMK + 4194304, O_SS = O_PMV + 4194304,
                 O_SSH = O_SS + 1572864, O_SK = O_SSH + 75776, O_SV = O_SK + 786432;
constexpr size_t T_HB = 0, T_D0 = (size_t)MT * DM * 2, T_P0 = O_PK * 4;
constexpr size_t T_SK = 0, T_SV = (size_t)16 * 1088 * MIXW * 2;
constexpr size_t WS_RWIN_T = 0;
constexpr size_t WS_DFIN_T = WS_RWIN_T + (size_t)RWIN_PAD * 1024 * 2;
constexpr size_t WS_WOUT_T = WS_DFIN_T + (size_t)DFIN * 1024 * 2;
constexpr size_t WS_WMEM_T = WS_WOUT_T + (size_t)2 * 1024 * 2048 * 2;
constexpr size_t WS_WUP_T = WS_WMEM_T + (size_t)2 * 1024 * 1024 * 2;
constexpr size_t WS_AUP_T = WS_WUP_T + (size_t)1536 * 64 * 2;
constexpr size_t WS_HM = WS_AUP_T + (size_t)1536 * 64 * 2;
constexpr size_t WS_MKB = WS_HM + (size_t)2 * 4096 * 1024 * 2;
constexpr size_t WS_MVB = WS_MKB + (size_t)2 * 8192 * 512 * 2;
constexpr size_t WS_BRANCH = WS_MVB + (size_t)2 * 8192 * 512 * 2;
constexpr size_t WS_GATE = WS_BRANCH + (size_t)MT * BR * 2;
constexpr size_t WS_KB = WS_GATE + (size_t)MT * BR * 2;
constexpr size_t WS_VB = WS_KB + (size_t)MT * MIXW * 2;
constexpr size_t WS_END = WS_VB + (size_t)MT * MIXW * 2;
constexpr size_t WS_EARR = WS_KB, WS_AARR = WS_VB, WS_X2 = WS_KB;

struct Args {
    const float* in[32];
    float* out;
    unsigned char* ws;
    int ph_lo, ph_hi;
};

typedef __bf16 nbf16x2 __attribute__((ext_vector_type(2)));
__device__ __forceinline__ unsigned pk_bf16(float lo, float hi) { const f32x2 v = {lo, hi}; return __builtin_bit_cast(unsigned, __builtin_convertvector(v, nbf16x2)); }
__device__ __forceinline__ bf16_t f2bf(float f) { return (bf16_t)(pk_bf16(f, 0.f) & 0xffffu); }
__device__ __forceinline__ float bf2f(bf16_t b) { return __uint_as_float(((unsigned)b) << 16); }
__device__ __forceinline__ float bflo(unsigned w) { return __uint_as_float(w << 16); }
__device__ __forceinline__ float bfhi(unsigned w) { return __uint_as_float(w & 0xffff0000u); }
__device__ __forceinline__ float dpp_f(float v, const int ctrl_sel) {
    const int x = __float_as_int(v);
    int r;
    if (ctrl_sel == 0) r = __builtin_amdgcn_update_dpp(x, x, 0xB1, 0xF, 0xF, false);
    else if (ctrl_sel == 1) r = __builtin_amdgcn_update_dpp(x, x, 0x4E, 0xF, 0xF, false);
    else if (ctrl_sel == 2) r = __builtin_amdgcn_update_dpp(x, x, 0x124, 0xF, 0xF, false);
    else r = __builtin_amdgcn_update_dpp(x, x, 0x128, 0xF, 0xF, false);
    return __int_as_float(r);
}
__device__ __forceinline__ float wave_sum(float v) {
    v += dpp_f(v, 0); v += dpp_f(v, 1); v += dpp_f(v, 2); v += dpp_f(v, 3);
    v += __shfl_xor(v, 16); v += __shfl_xor(v, 32);
    return v;
}
__device__ __forceinline__ const float* xrow(const Args& a, int row) { return row < MP ? a.in[0] + (size_t)row * DM : a.in[2] + (size_t)(row - MP) * DM; }

template <class T> __device__ __forceinline__ void launder(T*& p) { asm volatile("" : "+s"(p)); }

__device__ __forceinline__ void tr_tile(const float* __restrict__ W, int ldw, int k0, int n0, bf16_t* __restrict__ Wt, int ldt, int roff, float* tl) {
    const int tid = threadIdx.x;
#pragma unroll
    for (int i = 0; i < 8; ++i) { const int idx = tid + NTHR * i, k = idx >> 6, n = idx & 63; tl[k * 65 + n] = W[(size_t)(k0 + k) * ldw + n0 + n]; }
    __syncthreads();
#pragma unroll
    for (int i = 0; i < 8; ++i) { const int idx = tid + NTHR * i, n = idx >> 6, k = idx & 63; Wt[(size_t)(roff + n0 + n) * ldt + k0 + k] = f2bf(tl[k * 65 + n]); }
    __syncthreads();
}

__device__ __forceinline__ void norm_row_bf16(const float* __restrict__ x, const bf16_t* __restrict__ add, const float* __restrict__ w0, bf16_t* __restrict__ o0,
                                              const float* __restrict__ w1, bf16_t* __restrict__ o1, int lane) {
    f32x4 v[4]; float ss = 0.f;
#pragma unroll
    for (int i = 0; i < 4; ++i) {
        const int c = i * 256 + lane * 4;
        v[i] = __builtin_nontemporal_load((const f32x4*)(x + c));
        if (add) { const u32x2 d = *(const u32x2*)(add + c); v[i][0] += bflo(d.x); v[i][1] += bfhi(d.x); v[i][2] += bflo(d.y); v[i][3] += bfhi(d.y); }
        ss += v[i][0] * v[i][0] + v[i][1] * v[i][1] + v[i][2] * v[i][2] + v[i][3] * v[i][3];
    }
    ss = wave_sum(ss);
    const float rs = rsqrtf(ss * (1.0f / 1024.0f) + 1e-6f);
#pragma unroll
    for (int i = 0; i < 4; ++i) {
        const int c = i * 256 + lane * 4;
        const f32x4 g = *(const f32x4*)(w0 + c);
        u32x2 o; o.x = pk_bf16(v[i][0] * rs * g[0], v[i][1] * rs * g[1]); o.y = pk_bf16(v[i][2] * rs * g[2], v[i][3] * rs * g[3]);
        *(u32x2*)(o0 + c) = o;
        if (w1) { const f32x4 g1 = *(const f32x4*)(w1 + c);
            u32x2 q; q.x = pk_bf16(v[i][0] * rs * g1[0], v[i][1] * rs * g1[1]); q.y = pk_bf16(v[i][2] * rs * g1[2], v[i][3] * rs * g1[3]);
            *(u32x2*)(o1 + c) = q; }
    }
}

__device__ __forceinline__ void phase_prep(const Args& a, unsigned char* lds) {
    const int tid = threadIdx.x, wid = tid >> 6, lane = tid & 63;
    float* tl = (float*)lds;
    unsigned char* ws = a.ws;
    for (int j = blockIdx.x; j < 5200; j += gridDim.x) {
        const float* W; int ldw, kt, nt, ldt, roff; bf16_t* Wt; int r = j;
        if (r < 1824) { W = a.in[15]; ldw = RWIN; kt = r / 114; nt = r % 114; Wt = (bf16_t*)(ws + WS_RWIN_T); ldt = 1024; roff = 0; }
        else if (r < 1824 + 1792) { r -= 1824; W = a.in[26]; ldw = DFIN; kt = r / 112; nt = r % 112; Wt = (bf16_t*)(ws + WS_DFIN_T); ldt = 1024; roff = 0; }
        else if (r < 1824 + 1792 + 1024) { r -= 1824 + 1792; const int li = r >> 9; r &= 511; W = a.in[13] + (size_t)li * 2048 * 1024; ldw = 1024; kt = r / 16; nt = r % 16;
            Wt = (bf16_t*)(ws + WS_WOUT_T) + (size_t)li * 1024 * 2048; ldt = 2048; roff = 0; }
        else if (r < 1824 + 1792 + 1024 + 512) { r -= 1824 + 1792 + 1024; const int which = r >> 7, li = which >> 1, kv = which & 1; r &= 127;
            W = (kv ? a.in[12] : a.in[11]) + (size_t)li * 1024 * 512; ldw = 512; kt = r / 8; nt = r % 8;
            Wt = (bf16_t*)(ws + WS_WMEM_T) + (size_t)li * 1024 * 1024; ldt = 1024; roff = kv * 512; }
        else { r -= 1824 + 1792 + 1024 + 512; const int which = r / 24; nt = r % 24; kt = 0; W = which ? a.in[20] : a.in[18]; ldw = 1536;
            Wt = (bf16_t*)(ws + (which ? WS_AUP_T : WS_WUP_T)); ldt = 64; roff = 0; }
        tr_tile(W, ldw, kt * 64, nt * 64, Wt, ldt, roff, tl);
    }
    {
        u32x4* z = (u32x4*)(ws + WS_RWIN_T + (size_t)RWIN * 1024 * 2);
        const int n = (RWIN_PAD - RWIN) * 1024 * 2 / 16;
        for (int i = blockIdx.x * NTHR + tid; i < n; i += gridDim.x * NTHR) z[i] = (u32x4){0u, 0u, 0u, 0u};
    }
    {
        const int gw = blockIdx.x * 8 + wid, nw = gridDim.x * 8;
        bf16_t* HB = (bf16_t*)((unsigned char*)a.out + T_HB);
        bf16_t* HM = (bf16_t*)(ws + WS_HM);
        for (int r = gw; r < MT + 4096; r += nw) {
            if (r < MT) norm_row_bf16(xrow(a, r), nullptr, a.in[9], HB + (size_t)r * DM, nullptr, nullptr, lane);
            else { const int m = r - MT; norm_row_bf16(a.in[1] + (size_t)m * DM, nullptr, a.in[10], HM + (size_t)m * DM, a.in[10] + DM, HM + (size_t)(4096 + m) * DM, lane); }
        }
    }
    {
        const size_t n4 = (size_t)2 * 4096 * 512 / 4;
        for (size_t i = (size_t)blockIdx.x * NTHR + tid; i < 2 * n4; i += (size_t)gridDim.x * NTHR) {
            const int kv = i >= n4; const size_t e = (kv ? i - n4 : i) * 4;
            const int li = (int)(e / (4096 * 512)); const size_t rem = e % ((size_t)4096 * 512);
            const f32x4 v = *(const f32x4*)((kv ? a.in[8] : a.in[7]) + e);
            bf16_t* dst = (bf16_t*)(ws + (kv ? WS_MVB : WS_MKB)) + (size_t)li * 8192 * 512 + (size_t)4096 * 512 + rem;
            u32x2 o; o.x = pk_bf16(v[0], v[1]); o.y = pk_bf16(v[2], v[3]); *(u32x2*)dst = o;
        }
    }
}

__device__ __forceinline__ bool unit_next(int nM, int nN, int i, int G, int c, int& pm, int& pn) {
    const int nwg = nM * nN; const long L = (long)i * G + c; if (L >= nwg) return false;
    int wgid = (int)L; { const int q = nwg / 8, r = nwg % 8, xcd = wgid % 8, off = wgid / 8; wgid = (xcd < r ? xcd * (q + 1) : r * (q + 1) + (xcd - r) * q) + off; }
    const int nig = 8 * nN, gid = wgid / nig, fm = gid * 8, gsz = (nM - fm) < 8 ? (nM - fm) : 8;
    pm = fm + ((wgid % nig) % gsz); pn = (wgid % nig) / gsz; return true;
}

__device__ __forceinline__ u32x2 pk4(const f32x4 v) { return (u32x2){pk_bf16(v[0], v[1]), pk_bf16(v[2], v[3])}; }
__device__ __forceinline__ void st8_bf16(bf16_t* p, const f32x4 a, const f32x4 b) { __builtin_nontemporal_store((u32x4){pk_bf16(a[0], a[1]), pk_bf16(a[2], a[3]), pk_bf16(b[0], b[1]), pk_bf16(b[2], b[3])}, (u32x4*)p); }
__device__ __forceinline__ void st8_f32(float* p, const f32x4 a, const f32x4 b) { __builtin_nontemporal_store(a, (f32x4*)p); __builtin_nontemporal_store(b, (f32x4*)(p + 4)); }
__device__ __forceinline__ f32x4 silu4(const f32x4 v) { return (f32x4){v[0] / (1.f + __expf(-v[0])), v[1] / (1.f + __expf(-v[1])), v[2] / (1.f + __expf(-v[2])), v[3] / (1.f + __expf(-v[3]))}; }
struct EpiMem {
    float* out; unsigned char* ws; int li;
    __device__ __forceinline__ void wash() { launder(out); launder(ws); }
    __device__ __forceinline__ void store4(int row, int col, const f32x4 v) const {
        const size_t o = (size_t)li * 4096 * 512 + (size_t)row * 512, ob16 = (size_t)li * 8192 * 512 + (size_t)row * 512;
        if (col < 512) { __builtin_nontemporal_store(v, (f32x4*)(out + O_PMK + o + col)); __builtin_nontemporal_store(pk4(v), (u32x2*)((bf16_t*)(ws + WS_MKB) + ob16 + col)); }
        else { __builtin_nontemporal_store(v, (f32x4*)(out + O_PMV + o + col - 512)); __builtin_nontemporal_store(pk4(v), (u32x2*)((bf16_t*)(ws + WS_MVB) + ob16 + col - 512)); }
    }
    __device__ __forceinline__ void store8(int row, int col, const f32x4 v, const f32x4 w) const {
        const size_t o = (size_t)li * 4096 * 512 + (size_t)row * 512, ob16 = (size_t)li * 8192 * 512 + (size_t)row * 512;
        if (col < 512) { st8_f32(out + O_PMK + o + col, v, w); st8_bf16((bf16_t*)(ws + WS_MKB) + ob16 + col, v, w); }
        else { st8_f32(out + O_PMV + o + col - 512, v, w); st8_bf16((bf16_t*)(ws + WS_MVB) + ob16 + col - 512, v, w); }
    }
};
struct EpiIn0 {
    float* out; unsigned char* ws;
    __device__ __forceinline__ void wash() { launder(out); launder(ws); }
    __device__ __forceinline__ void store4(int row, int col, const f32x4 v) const {
        if (col < RWP) {
            __builtin_nontemporal_store(pk4(v), (u32x2*)((bf16_t*)((unsigned char*)out + T_P0) + (size_t)row * RWP + col));
            if (row < MP) { if ((row & 4095) == 4095) *(f32x4*)(out + O_PSH + (size_t)(row >> 12) * RWP + col) = v; }
            else { const int r2 = row - MP; if ((r2 & 31) == 31) *(f32x4*)(out + O_SSH + (size_t)(r2 >> 5) * RWP + col) = v; }
        } else if (col < RWP + 512) __builtin_nontemporal_store(pk4(v), (u32x2*)((bf16_t*)(ws + WS_BRANCH) + (size_t)row * BR + 1536 + (col - RWP)));
        else if (col < RWIN) __builtin_nontemporal_store(pk4(silu4(v)), (u32x2*)((bf16_t*)(ws + WS_GATE) + (size_t)row * BR + (col - RWP - 512)));
    }
    __device__ __forceinline__ void store8(int row, int col, const f32x4 v, const f32x4 w) const {
        if (col < RWP) {
            st8_bf16((bf16_t*)((unsigned char*)out + T_P0) + (size_t)row * RWP + col, v, w);
            if (row < MP) { if ((row & 4095) == 4095) { float* p = out + O_PSH + (size_t)(row >> 12) * RWP + col; *(f32x4*)p = v; *(f32x4*)(p + 4) = w; } }
            else { const int r2 = row - MP; if ((r2 & 31) == 31) { float* p = out + O_SSH + (size_t)(r2 >> 5) * RWP + col; *(f32x4*)p = v; *(f32x4*)(p + 4) = w; } }
        } else if (col < RWP + 512) st8_bf16((bf16_t*)(ws + WS_BRANCH) + (size_t)row * BR + 1536 + (col - RWP), v, w);
        else if (col < RWIN) st8_bf16((bf16_t*)(ws + WS_GATE) + (size_t)row * BR + (col - RWP - 512), silu4(v), silu4(w));
    }
};
struct EpiIn1 {
    float* out; unsigned char* ws;
    __device__ __forceinline__ void wash() { launder(out); launder(ws); }
    __device__ __forceinline__ void store4(int row, int col, const f32x4 v) const {
        if (col < 1536) __builtin_nontemporal_store(pk4(v), (u32x2*)((bf16_t*)(ws + WS_BRANCH) + (size_t)row * BR + col));
        else if (col < 3072) { const int c = col - 1536; __builtin_nontemporal_store(pk4(v), (u32x2*)((bf16_t*)(ws + WS_KB) + (size_t)row * MIXW + c));
            if (row < MP) __builtin_nontemporal_store(v, (f32x4*)(out + O_PK + (size_t)row * MIXW + c)); else __builtin_nontemporal_store(v, (f32x4*)(out + O_SK + (size_t)(row - MP) * MIXW + c)); }
        else if (col < 4608) { const int c = col - 3072; __builtin_nontemporal_store(pk4(v), (u32x2*)((bf16_t*)(ws + WS_VB) + (size_t)row * MIXW + c));
            if (row < MP) __builtin_nontemporal_store(v, (f32x4*)(out + O_PV + (size_t)row * MIXW + c)); else __builtin_nontemporal_store(v, (f32x4*)(out + O_SV + (size_t)(row - MP) * MIXW + c)); }
        else if (col < 5120) __builtin_nontemporal_store(pk4(v), (u32x2*)((bf16_t*)(ws + WS_BRANCH) + (size_t)row * BR + 1536 + (col - 4608)));
        else __builtin_nontemporal_store(pk4(silu4(v)), (u32x2*)((bf16_t*)(ws + WS_GATE) + (size_t)row * BR + (col - 5120)));
    }
    __device__ __forceinline__ void store8(int row, int col, const f32x4 v, const f32x4 w) const {
        if (col < 1536) st8_bf16((bf16_t*)(ws + WS_BRANCH) + (size_t)row * BR + col, v, w);
        else if (col < 3072) { const int c = col - 1536; st8_bf16((bf16_t*)(ws + WS_KB) + (size_t)row * MIXW + c, v, w);
            if (row < MP) st8_f32(out + O_PK + (size_t)row * MIXW + c, v, w); else st8_f32(out + O_SK + (size_t)(row - MP) * MIXW + c, v, w); }
        else if (col < 4608) { const int c = col - 3072; st8_bf16((bf16_t*)(ws + WS_VB) + (size_t)row * MIXW + c, v, w);
            if (row < MP) st8_f32(out + O_PV + (size_t)row * MIXW + c, v, w); else st8_f32(out + O_SV + (size_t)(row - MP) * MIXW + c, v, w); }
        else if (col < 5120) st8_bf16((bf16_t*)(ws + WS_BRANCH) + (size_t)row * BR + 1536 + (col - 4608), v, w);
        else st8_bf16((bf16_t*)(ws + WS_GATE) + (size_t)row * BR + (col - 5120), silu4(v), silu4(w));
    }
};
struct EpiOut0 {
    float* out;
    __device__ __forceinline__ void wash() { launder(out); }
    __device__ __forceinline__ void store4(int row, int col, const f32x4 v) const { __builtin_nontemporal_store(pk4(v), (u32x2*)((bf16_t*)((unsigned char*)out + T_D0) + (size_t)row * DM + col)); }
    __device__ __forceinline__ void store8(int row, int col, const f32x4 v, const f32x4 w) const { st8_bf16((bf16_t*)((unsigned char*)out + T_D0) + (size_t)row * DM + col, v, w); }
};
struct EpiOut1 {
    const float* xp; const float* xs; float* out; unsigned char* ws;
    __device__ __forceinline__ void wash() { launder(xp); launder(xs); launder(out); launder(ws); }
    __device__ __forceinline__ void store4(int row, int col, const f32x4 v) const {
        const f32x4 x = row < MP ? *(const f32x4*)(xp + (size_t)row * DM + col) : *(const f32x4*)(xs + (size_t)(row - MP) * DM + col);
        const u32x2 d = *(const u32x2*)((const bf16_t*)((const unsigned char*)out + T_D0) + (size_t)row * DM + col);
        const f32x4 d0 = {bflo(d.x), bfhi(d.x), bflo(d.y), bfhi(d.y)};
        __builtin_nontemporal_store(x + d0 + v, (f32x4*)((float*)(ws + WS_X2) + (size_t)row * DM + col));
    }
    __device__ __forceinline__ void store8(int row, int col, const f32x4 v, const f32x4 w) const { store4(row, col, v); store4(row, col + 4, w); }
};

namespace pg8 {
#define PG8_LAS __attribute__((address_space(3)))
typedef unsigned short bf16_t;
typedef short bf16x8 __attribute__((ext_vector_type(8)));
typedef float f32x4 __attribute__((ext_vector_type(4)));
typedef unsigned u32x4 __attribute__((ext_vector_type(4)));
constexpr int BM = 256, BK = 64, HALF = 128, HTB = HALF * BK * 2  , STAGE_BYTES = 8 * HTB, NXCD = 8, WGM = 8;

__host__ __device__ __forceinline__ int lds_byte(int r, int c) { const int st = (r >> 4) * 2 + (c >> 5), rr = r & 15, cc = c & 31, ob = rr * 64 + cc * 2; return st * 1024 + (ob ^ (((ob >> 9) & 1) << 5)); }
__host__ __device__ __forceinline__ void stage_rc(int b, int& R, int& C) { const int st = b / 1024, sb = b % 1024, swz = sb ^ (((sb >> 9) & 1) << 5); R = (st >> 1) * 16 + swz / 64; C = (st & 1) * 32 + (swz % 64) / 2; }
__host__ __device__ __forceinline__ int perm32(int rho) { const int n = rho >> 4, i = rho & 15; return 8 * (i >> 2) + 4 * n + (i & 3); }

struct Unit { int pm, pn; };
struct Gemm { const bf16_t* A; const bf16_t* Bt; int M, N, K; };

struct StaticOrder {
    int nM, nN, nwg, G, c;
    __host__ __device__ __forceinline__ void init(int M, int N, int G_, int c_) { nM = M / BM; nN = N / BM; nwg = nM * nN; G = G_; c = c_; }
    __host__ __device__ __forceinline__ bool next(int i, Unit& u) const {
        const long L = (long)i * G + c; if (L >= nwg) return false;
        int wgid = (int)L; { const int q = nwg / NXCD, r = nwg % NXCD, xcd = wgid % NXCD, off = wgid / NXCD; wgid = (xcd < r ? xcd * (q + 1) : r * (q + 1) + (xcd - r) * q) + off; }
        const int nig = WGM * nN, gid = wgid / nig, fm = gid * WGM, gsz = (nM - fm) < WGM ? (nM - fm) : WGM;
        u.pm = fm + ((wgid % nig) % gsz); u.pn = (wgid % nig) / gsz; return true;
    }
    __device__ __forceinline__ void a_ready(const Unit&) const {}
    __device__ __forceinline__ void done(const Unit&) const {}
};
template <class Epi, class Sched, bool ALIGN_EPI = false, bool SP2 = false>
__device__ __forceinline__ void gemm_phase(PG8_LAS unsigned char* lds, const Gemm g, const Sched& S, const Epi& E) {
    const int tid = threadIdx.x, wid = __builtin_amdgcn_readfirstlane(tid >> 6), lane = tid & 63, wr = wid >> 2, wc = wid & 3, fr = lane & 15, fq = lane >> 4;
    const int K = g.K, nt = K / BK;
    unsigned voffA[2], voffB[2];
#pragma unroll
    for (int i = 0; i < 2; ++i) { int R, C; stage_rc(tid * 16 + i * 8192, R, C); const int Rb = Epi::PERM ? ((R & ~31) + perm32(R & 31)) : R;
        voffA[i] = (unsigned)(R * K + C) * 2u; voffB[i] = (unsigned)(Rb * K + C) * 2u; }
    const size_t kstep = (size_t)(BK * 2);
    const size_t hstep = (size_t)HALF * K * 2;
    const size_t tstep = 2 * hstep;
    const unsigned ldsw = (unsigned)wid * 1024u;
    const int aoff = lds_byte(wr * 64 + fr, fq * 8), boff = lds_byte(wc * 32 + fr, fq * 8);
#define PG8_SA(b, h) (((b) * 2 + (h)) * HTB)
#define PG8_SB(b, h) ((4 + (b) * 2 + (h)) * HTB)
#define PG8_STAGE(bufoff, gbase, voff) do { _Pragma("unroll") for (int _i = 0; _i < 2; ++_i) \
        __builtin_amdgcn_global_load_lds((const unsigned*)((const char*)(gbase) + (voff)[_i]), (PG8_LAS unsigned*)(lds + (bufoff) + ldsw + _i * 8192), 16, 0, 0); } while (0)
#define PG8_LDA(dst, b, h) do { _Pragma("unroll") for (int m = 0; m < 4; ++m) _Pragma("unroll") for (int k = 0; k < 2; ++k) dst[m][k] = *(const PG8_LAS bf16x8*)(lds + PG8_SA(b, h) + aoff + m * 2048 + k * 1024); } while (0)
#define PG8_LDB(dst, b, h) do { _Pragma("unroll") for (int n = 0; n < 2; ++n) _Pragma("unroll") for (int k = 0; k < 2; ++k) dst[n][k] = *(const PG8_LAS bf16x8*)(lds + PG8_SB(b, h) + boff + n * 2048 + k * 1024); } while (0)
#define PG8_MMA(ai, bj, At, Bt) do { __builtin_amdgcn_s_setprio(1); _Pragma("unroll") for (int m = 0; m < 4; ++m) _Pragma("unroll") for (int n = 0; n < 2; ++n) _Pragma("unroll") for (int k = 0; k < 2; ++k) \
        acc[ai][bj][m][n] = __builtin_amdgcn_mfma_f32_16x16x32_bf16(Bt[n][k], At[m][k], acc[ai][bj][m][n], 0, 0, 0); __builtin_amdgcn_s_setprio(0); } while (0)
#define PG8_WAIT_V(n) asm volatile("s_waitcnt vmcnt(" #n ")" ::: "memory")
#define PG8_WAIT_L(n) asm volatile("s_waitcnt lgkmcnt(" #n ")" ::: "memory")
#define PG8_BAR __builtin_amdgcn_s_barrier()
#define PG8_SCHED __builtin_amdgcn_sched_barrier(0)
    Unit cur, nxt; int ui = 0;
    if (!S.next(0, cur)) return;
    f32x4 acc[2][2][4][2];
#pragma unroll
    for (int a = 0; a < 2; ++a)
#pragma unroll
        for (int b = 0; b < 2; ++b)
#pragma unroll
            for (int m = 0; m < 4; ++m)
#pragma unroll
                for (int n = 0; n < 2; ++n) acc[a][b][m][n] = (f32x4){0.f, 0.f, 0.f, 0.f};
    bf16x8 At[4][2], B0[2][2], B1[2][2];
    const char* cA = (const char*)g.A + (size_t)cur.pm * tstep; const char* cB = (const char*)g.Bt + (size_t)cur.pn * tstep;
    S.a_ready(cur);
    if constexpr (SP2) {
        PG8_STAGE(PG8_SB(0, 0), cB, voffB); PG8_STAGE(PG8_SB(0, 1), cB + hstep, voffB); PG8_STAGE(PG8_SA(0, 0), cA, voffA); PG8_STAGE(PG8_SA(0, 1), cA + hstep, voffA);
        if (wr == 1) PG8_BAR;
        PG8_WAIT_V(2); PG8_BAR;
        PG8_STAGE(PG8_SB(1, 0), cB + kstep, voffB); PG8_STAGE(PG8_SA(1, 0), cA + kstep, voffA); PG8_STAGE(PG8_SB(1, 1), cB + hstep + kstep, voffB);
        PG8_WAIT_V(6); PG8_BAR;
    } else {
        PG8_STAGE(PG8_SB(0, 0), cB, voffB); PG8_STAGE(PG8_SA(0, 0), cA, voffA); PG8_STAGE(PG8_SB(0, 1), cB + hstep, voffB); PG8_STAGE(PG8_SA(0, 1), cA + hstep, voffA);
        if (wr == 1) PG8_BAR;
        PG8_WAIT_V(4); PG8_BAR;
        PG8_STAGE(PG8_SB(1, 0), cB + kstep, voffB); PG8_STAGE(PG8_SA(1, 0), cA + kstep, voffA); PG8_STAGE(PG8_SB(1, 1), cB + hstep + kstep, voffB);
        PG8_WAIT_V(6); PG8_BAR;
    }
    for (;;) {
        const bool has_next = S.next(ui + 1, nxt);
        const char* nA = has_next ? (const char*)g.A + (size_t)nxt.pm * tstep : cA; const char* nB = has_next ? (const char*)g.Bt + (size_t)nxt.pn * tstep : cB;
        for (int t = 0; t < nt; t += 2) {
            const bool last = (t == nt - 2);
            const char* a1 = cA + (size_t)(t + 1) * kstep;
            const char* a2 = last ? nA : cA + (size_t)(t + 2) * kstep; const char* b2 = last ? nB : cB + (size_t)(t + 2) * kstep;
            const char* a3 = a2 + kstep; const char* b3 = b2 + kstep;
            if (last && has_next) S.a_ready(nxt);
            if constexpr (SP2) {
            PG8_LDB(B0, 0, 0); PG8_LDB(B1, 0, 1); PG8_SCHED; PG8_LDA(At, 0, 0); PG8_STAGE(PG8_SA(1, 1), a1 + hstep, voffA);
            PG8_WAIT_V(8); PG8_WAIT_L(0); PG8_BAR; PG8_MMA(0, 0, At, B0); PG8_MMA(0, 1, At, B1); PG8_BAR; PG8_SCHED;
            PG8_LDA(At, 0, 1); PG8_STAGE(PG8_SB(0, 0), b2, voffB); PG8_STAGE(PG8_SB(0, 1), b2 + hstep, voffB); PG8_STAGE(PG8_SA(0, 0), a2, voffA);
            PG8_WAIT_V(8); PG8_WAIT_L(0); PG8_BAR; PG8_MMA(1, 0, At, B0); PG8_MMA(1, 1, At, B1); PG8_BAR; PG8_SCHED;
            PG8_LDB(B0, 1, 0); PG8_LDB(B1, 1, 1); PG8_SCHED; PG8_LDA(At, 1, 0); PG8_STAGE(PG8_SA(0, 1), a2 + hstep, voffA);
            PG8_WAIT_V(8); PG8_WAIT_L(0); PG8_BAR; PG8_MMA(0, 0, At, B0); PG8_MMA(0, 1, At, B1); PG8_BAR; PG8_SCHED;
            PG8_LDA(At, 1, 1); PG8_STAGE(PG8_SB(1, 0), b3, voffB); PG8_STAGE(PG8_SB(1, 1), b3 + hstep, voffB); PG8_STAGE(PG8_SA(1, 0), a3, voffA);
            PG8_WAIT_V(8); PG8_WAIT_L(0); PG8_BAR; PG8_MMA(1, 0, At, B0); PG8_MMA(1, 1, At, B1); PG8_BAR; PG8_SCHED;
            } else {
            PG8_LDB(B0, 0, 0); PG8_SCHED; PG8_LDA(At, 0, 0); PG8_STAGE(PG8_SA(1, 1), a1 + hstep, voffA);
            PG8_WAIT_L(8); PG8_BAR; PG8_WAIT_L(0); PG8_MMA(0, 0, At, B0); PG8_BAR; PG8_SCHED;
            PG8_LDB(B1, 0, 1); PG8_STAGE(PG8_SB(0, 0), b2, voffB);
            PG8_BAR; PG8_WAIT_L(0); PG8_MMA(0, 1, At, B1); PG8_BAR;
            PG8_LDA(At, 0, 1); PG8_STAGE(PG8_SA(0, 0), a2, voffA);
            PG8_BAR; PG8_WAIT_L(0); PG8_MMA(1, 0, At, B0); PG8_BAR; PG8_SCHED;
            PG8_STAGE(PG8_SB(0, 1), b2 + hstep, voffB);
            PG8_WAIT_V(6); PG8_BAR; PG8_MMA(1, 1, At, B1); PG8_BAR;
            PG8_LDB(B0, 1, 0); PG8_SCHED; PG8_LDA(At, 1, 0); PG8_STAGE(PG8_SA(0, 1), a2 + hstep, voffA);
            PG8_WAIT_L(8); PG8_BAR; PG8_WAIT_L(0); PG8_MMA(0, 0, At, B0); PG8_BAR; PG8_SCHED;
            PG8_LDB(B1, 1, 1); PG8_STAGE(PG8_SB(1, 0), b3, voffB);
            PG8_BAR; PG8_WAIT_L(0); PG8_MMA(0, 1, At, B1); PG8_BAR;
            PG8_LDA(At, 1, 1); PG8_STAGE(PG8_SA(1, 0), a3, voffA);
            PG8_BAR; PG8_WAIT_L(0); PG8_MMA(1, 0, At, B0); PG8_BAR; PG8_SCHED;
            PG8_STAGE(PG8_SB(1, 1), b3 + hstep, voffB);
            PG8_WAIT_V(6); PG8_BAR; PG8_MMA(1, 1, At, B1); PG8_BAR;
            }
        }
        if constexpr (ALIGN_EPI) { if (wr == 0) PG8_BAR; }
        if constexpr (!Epi::AFTER_DRAIN) { E(acc, cur, wr, wc, fr, fq); S.done(cur); }
        if (!has_next) break;
#pragma unroll
        for (int a = 0; a < 2; ++a)
#pragma unroll
            for (int b = 0; b < 2; ++b)
#pragma unroll
                for (int m = 0; m < 4; ++m)
#pragma unroll
                    for (int n = 0; n < 2; ++n) acc[a][b][m][n] = (f32x4){0.f, 0.f, 0.f, 0.f};
        cur = nxt; cA = nA; cB = nB; ++ui;
        if constexpr (ALIGN_EPI) { if (wr == 1) PG8_BAR; }
    }
    PG8_WAIT_V(0);
    if constexpr (!ALIGN_EPI) { if (wr == 0) PG8_BAR; }
    PG8_BAR;
    if constexpr (Epi::AFTER_DRAIN) { E.fused(acc, cur, wr, wc, fr, fq, lds, wid, lane); S.done(cur); }
#undef PG8_SA
#undef PG8_SB
#undef PG8_STAGE
#undef PG8_LDA
#undef PG8_LDB
#undef PG8_MMA
#undef PG8_WAIT_V
#undef PG8_WAIT_L
#undef PG8_BAR
#undef PG8_SCHED
}
}

template <class E1> struct EpiAdapt {
    static constexpr bool PERM = true, AFTER_DRAIN = false;
    E1 e;
    __device__ __forceinline__ void operator()(const pg8::f32x4 (&acc)[2][2][4][2], const pg8::Unit& u, int wr, int wc, int fr, int fq) const {
        E1 el = e; el.wash();
        const int row0 = u.pm * 256 + wr * 64 + fr, col0 = u.pn * 256 + wc * 32 + 8 * fq;
#define EA_BLK(ai, bj, m) { const pg8::f32x4 c0 = acc[ai][bj][m][0], c1 = acc[ai][bj][m][1]; \
        el.store8(row0 + (ai) * 128 + (m) * 16, col0 + (bj) * 128, (f32x4){c0[0], c0[1], c0[2], c0[3]}, (f32x4){c1[0], c1[1], c1[2], c1[3]}); }
#define EA_M(ai, bj) EA_BLK(ai, bj, 0) EA_BLK(ai, bj, 1) EA_BLK(ai, bj, 2) EA_BLK(ai, bj, 3)
        EA_M(0, 0) EA_M(0, 1) EA_M(1, 0) EA_M(1, 1)
#undef EA_M
#undef EA_BLK
    }
};
template <class E1>
__device__ __forceinline__ void gemm_pg8(unsigned char* lds, const bf16_t* A, const bf16_t* Bt, int M, int N, int K, const E1& e, int shift = 0) {
    pg8::Gemm g{A, Bt, M, N, K};
    pg8::StaticOrder S; S.init(M, N, (int)gridDim.x, (int)((blockIdx.x + shift) % gridDim.x));
    EpiAdapt<E1> E{e};
    pg8::gemm_phase<EpiAdapt<E1>, pg8::StaticOrder, true, true>((PG8_LAS unsigned char*)lds, g, S, E);
}

__device__ __forceinline__ void phase_lora(const Args& a) {
    const int lane = threadIdx.x & 63, gw = blockIdx.x * 8 + (threadIdx.x >> 6), nw = gridDim.x * 8;
    const int tk = lane & 15, kg = lane >> 4;
    const bf16_t* P0 = (const bf16_t*)((const unsigned char*)a.out + T_P0);
    const bf16_t* WU = (const bf16_t*)(a.ws + WS_WUP_T);
    const bf16_t* AU = (const bf16_t*)(a.ws + WS_AUP_T);
    _Float16* EA = (_Float16*)(a.ws + WS_EARR);
    _Float16* AA = (_Float16*)(a.ws + WS_AARR);
    const float* mu = a.in[16]; const float* w0 = a.in[17]; const float* a0 = a.in[19];
    auto do_unit = [&](const int u, const int nt0, const int nt1) __attribute__((always_inline)) {
        const int row = u * 16 + tk;
        const bool smp = row >= MP; const int t = smp ? ((row - MP) & 31) : (row & 4095); const int b = smp ? ((row - MP) >> 5) : (row >> 12);
        bf16x8 act[2][2];
#pragma unroll
        for (int which = 0; which < 2; ++which)
#pragma unroll
            for (int ks = 0; ks < 2; ++ks) {
                const int col = 4608 + which * 64 + ks * 32 + kg * 8;
                const u32x4 cur = *(const u32x4*)(P0 + (size_t)row * RWP + col);
                float pv[8];
                if (t > 0) { const u32x4 pr = *(const u32x4*)(P0 + (size_t)(row - 1) * RWP + col);
#pragma unroll
                    for (int e = 0; e < 4; ++e) { pv[2 * e] = bflo(pr[e]); pv[2 * e + 1] = bfhi(pr[e]); } }
                else if (smp) { const float* ss = a.in[4] + (size_t)b * RWP + col;
#pragma unroll
                    for (int e = 0; e < 8; ++e) pv[e] = ss[e]; }
                else {
#pragma unroll
                    for (int e = 0; e < 8; ++e) pv[e] = 0.f; }
                float xv[8];
#pragma unroll
                for (int e = 0; e < 8; ++e) { const float c = (e & 1) ? bfhi(cur[e >> 1]) : bflo(cur[e >> 1]); const float x = c + mu[col + e] * (pv[e] - c); xv[e] = which == 0 ? tanhf(x) : x; }
                u32x4 pk; pk.x = pk_bf16(xv[0], xv[1]); pk.y = pk_bf16(xv[2], xv[3]); pk.z = pk_bf16(xv[4], xv[5]); pk.w = pk_bf16(xv[6], xv[7]);
                act[which][ks] = __builtin_bit_cast(bf16x8, pk);
            }
        for (int nt = nt0; nt < nt1; ++nt) {
            const int n = nt * 16 + tk;
            const bf16x8 w0f = *(const bf16x8*)(WU + n * 64 + kg * 8), w1f = *(const bf16x8*)(WU + n * 64 + 32 + kg * 8);
            const bf16x8 a0f = *(const bf16x8*)(AU + n * 64 + kg * 8), a1f = *(const bf16x8*)(AU + n * 64 + 32 + kg * 8);
            f32x4 dw = {0.f, 0.f, 0.f, 0.f}, da = {0.f, 0.f, 0.f, 0.f};
            dw = __builtin_amdgcn_mfma_f32_16x16x32_bf16(w0f, act[0][0], dw, 0, 0, 0);
            dw = __builtin_amdgcn_mfma_f32_16x16x32_bf16(w1f, act[0][1], dw, 0, 0, 0);
            da = __builtin_amdgcn_mfma_f32_16x16x32_bf16(a0f, act[1][0], da, 0, 0, 0);
            da = __builtin_amdgcn_mfma_f32_16x16x32_bf16(a1f, act[1][1], da, 0, 0, 0);
            const int n0 = nt * 16 + kg * 4;
            const f32x4 w0v = *(const f32x4*)(w0 + n0), a0v = *(const f32x4*)(a0 + n0);
            h16x4 eo, ao;
#pragma unroll
            for (int j = 0; j < 4; ++j) {
                const float x = -(w0v[j] + dw[j]);
                const float sp = fmaxf(x, 0.f) + __logf(1.f + __expf(-fabsf(x)));
                eo[j] = (_Float16)__expf(-sp - 0.5f);
                ao[j] = (_Float16)(1.f / (1.f + __expf(-(a0v[j] + da[j]))));
            }
            *(h16x4*)(EA + (size_t)row * MIXW + n0) = eo;
            *(h16x4*)(AA + (size_t)row * MIXW + n0) = ao;
        }
    };
    const int n_units = MT / 16, n_main = (n_units / nw) * nw;
    for (int u = gw; u < n_main; u += nw) do_unit(u, 0, 96);
    for (int u = n_main + (int)blockIdx.x; u < n_units; u += (int)gridDim.x) { const int w = (int)(threadIdx.x >> 6); do_unit(u, 12 * w, 12 * w + 12); }
}

__device__ __forceinline__ void phase_scan(const Args& a, unsigned char* lds) {
    const int tid = threadIdx.x, wid = tid >> 6, lane = tid & 63;
    float* vec = (float*)lds;
    float* ybuf = (float*)(lds + 98304);
    float* bon = (float*)(lds + 114688);
    const bf16_t* P0 = (const bf16_t*)((const unsigned char*)a.out + T_P0);
    const _Float16* EA = (const _Float16*)(a.ws + WS_EARR);
    const _Float16* AA = (const _Float16*)(a.ws + WS_AARR);
    const bf16_t* GT = (const bf16_t*)(a.ws + WS_GATE);
    bf16_t* BRc = (bf16_t*)(a.ws + WS_BRANCH);
    const bool is_scan = wid < 4;
    const int hd = is_scan ? (wid >> 1) : ((wid - 4) >> 1), hw = (wid - 4) & 1;
    const int srow = (wid & 1) * 32 + (lane >> 1), cb = (lane & 1) * 32;
    const int item_stride = (int)gridDim.x > 192 ? ((int)blockIdx.x < 192 ? 384 : (int)gridDim.x - 192) : (int)gridDim.x;
    for (int item = blockIdx.x; item < 384; item += item_stride) {
        const bool smp = item >= 192; const int pair = smp ? item - 192 : item;
        const int T = smp ? 32 : 4096, nch = T / 16;
        const int bh = pair * 2 + hd, b = bh / 24, h = bh % 24;
        const int row0 = smp ? MP + b * 32 : b * 4096;
        const int hcol = h * 64 + lane;
        f32x2 S2[40];
#define HC4(k) ((f32x4){S2[2 * (k)].x, S2[2 * (k)].y, S2[2 * (k) + 1].x, S2[2 * (k) + 1].y})
#define PFU(pp, k) S2[16 + (pp) * 9 + (k)]
#pragma unroll
        for (int j = 0; j < 40; ++j) S2[j] = (f32x2){0.f, 0.f};
        const int hss = lane >> 4, hc4 = (lane & 15) * 4, hcol4 = h * 64 + hc4;
        if (is_scan) {
            if (smp) { const float* s0 = a.in[3] + ((size_t)bh * 64 + srow) * 64 + cb;
#pragma unroll
                for (int j = 0; j < 8; ++j) { const f32x4 q = *(const f32x4*)(s0 + 4 * j); S2[2 * j] = (f32x2){q[0], q[1]}; S2[2 * j + 1] = (f32x2){q[2], q[3]}; } }
        } else {
            const float* cp[8] = {a.in[16] + hcol4, a.in[16] + 1536 + hcol4, a.in[16] + 3072 + hcol4, a.in[21] + hcol4, a.in[22] + hcol4, a.in[23] + hcol4, a.in[24] + hcol4, a.in[25] + hcol4};
#pragma unroll
            for (int k = 0; k < 8; ++k) { const f32x4 q = *(const f32x4*)cp[k]; S2[2 * k] = (f32x2){q[0], q[1]}; S2[2 * k + 1] = (f32x2){q[2], q[3]}; }
        }
#define LOAD_PREP(c, cg, N) \
        _Pragma("unroll") for (int pp = 0; pp < 2; ++pp) { const int s = (2 * hw + pp) * 4 + hss; \
            if ((c) < nch) { const int t = (c) * 16 + s, row = row0 + t; const bf16_t* pr = P0 + (size_t)row * RWP + hcol4; \
                N[pp][0] = *(const u32x2*)pr; N[pp][1] = *(const u32x2*)(pr + 1536); N[pp][2] = *(const u32x2*)(pr + 3072); \
                if (t > 0) { N[pp][3] = *(const u32x2*)(pr - RWP); N[pp][4] = *(const u32x2*)(pr + 1536 - RWP); N[pp][5] = *(const u32x2*)(pr + 3072 - RWP); } \
                else if (smp) { const float* ss = a.in[4] + (size_t)b * RWP + hcol4; \
                    _Pragma("unroll") for (int q = 0; q < 3; ++q) { const f32x4 x = *(const f32x4*)(ss + 1536 * q); N[pp][3 + q] = (u32x2){pk_bf16(x[0], x[1]), pk_bf16(x[2], x[3])}; } } \
                else { N[pp][3] = (u32x2){0u, 0u}; N[pp][4] = (u32x2){0u, 0u}; N[pp][5] = (u32x2){0u, 0u}; } \
                N[pp][6] = *(const u32x2*)(EA + (size_t)row * MIXW + hcol4); N[pp][7] = *(const u32x2*)(AA + (size_t)row * MIXW + hcol4); } \
            if ((cg) >= 0 && (cg) < nch) N[pp][8] = *(const u32x2*)(GT + (size_t)(row0 + (cg) * 16 + s) * BR + hcol4); }
        if (!is_scan) {
            u32x2 N[2][9];
#pragma unroll
            for (int pp = 0; pp < 2; ++pp)
#pragma unroll
                for (int k = 0; k < 9; ++k) N[pp][k] = (u32x2){0u, 0u};
            LOAD_PREP(0, -1, N)
#pragma unroll
            for (int pp = 0; pp < 2; ++pp)
#pragma unroll
                for (int k = 0; k < 9; ++k) PFU(pp, k) = __builtin_bit_cast(f32x2, N[pp][k]);
        }
        for (int it = 0; it < nch + 2; ++it) {
            if (is_scan) {
                if (it >= 1 && it <= nch) {
                    const int c = it - 1, buf = c & 1;
                    const float* vb = vec + (size_t)((buf * 2 + hd) * 16) * 384 + cb;
                    float* yb = ybuf + ((buf * 2 + hd) * 16) * 64;
#define SB __builtin_amdgcn_sched_barrier(0)
#define LDG(G, c8) { const float* p_ = vs + (c8) * 8; G[0] = *(const f32x4*)(p_ + 192); G[1] = *(const f32x4*)(p_ + 196); G[2] = *(const f32x4*)(p_ + 320); G[3] = *(const f32x4*)(p_ + 324); \
                     G[4] = *(const f32x4*)(p_ + 64); G[5] = *(const f32x4*)(p_ + 68); G[6] = *(const f32x4*)(p_); G[7] = *(const f32x4*)(p_ + 4); }
#define CMP1(G, h, j) { f32x2 t0 = sa2 * (f32x2){G[2 + h][0], G[2 + h][1]} + v2 * (f32x2){G[4 + h][0], G[4 + h][1]}; \
                        f32x2 t1 = sa2 * (f32x2){G[2 + h][2], G[2 + h][3]} + v2 * (f32x2){G[4 + h][2], G[4 + h][3]}; \
                        S2[2 * (j)] = S2[2 * (j)] * (f32x2){G[h][0], G[h][1]} + t0; S2[2 * (j) + 1] = S2[2 * (j) + 1] * (f32x2){G[h][2], G[h][3]} + t1; \
                        y0 += S2[2 * (j)] * (f32x2){G[6 + h][0], G[6 + h][1]}; y1 += S2[2 * (j) + 1] * (f32x2){G[6 + h][2], G[6 + h][3]}; }
#define CMP(G, c8) { CMP1(G, 0, 2 * (c8)) CMP1(G, 1, 2 * (c8) + 1) }
                    f32x4 KA[8];
#pragma unroll
                    for (int j = 0; j < 8; ++j) KA[j] = *(const f32x4*)(vb + 256 + 4 * j);
#pragma nounroll
                    for (int s = 0; s < 16; ++s) {
                        const float* vs = vb + s * 384;
                        const float vi = vs[128 - cb + srow];
                        f32x4 G0[8], G1[8], G2[8];
                        LDG(G0, 0) SB;
                        LDG(G1, 1) SB;
                        f32x2 c0 = {0.f, 0.f}, c1 = {0.f, 0.f};
#pragma unroll
                        for (int j = 0; j < 8; ++j) { c0 += S2[2 * j] * (f32x2){KA[j][0], KA[j][1]}; c1 += S2[2 * j + 1] * (f32x2){KA[j][2], KA[j][3]}; }
                        float cs = (c0.x + c0.y) + (c1.x + c1.y);
                        cs += dpp_f(cs, 0);
                        const float sa = -cs;
                        const f32x2 sa2 = {sa, sa}, v2 = {vi, vi};
                        f32x2 y0 = {0.f, 0.f}, y1 = {0.f, 0.f};
                        SB; LDG(G2, 2) SB; CMP(G0, 0) SB;
                        LDG(G0, 3) SB; CMP(G1, 1) SB;
                        CMP(G2, 2) SB;
#pragma unroll
                        for (int j = 0; j < 8; ++j) KA[j] = *(const f32x4*)(vs + 384 + 256 + 4 * j);
                        SB; CMP(G0, 3) SB;
                        float ys = (y0.x + y0.y) + (y1.x + y1.y);
                        ys += dpp_f(ys, 0);
                        if ((lane & 1) == 0) yb[s * 64 + srow] = ys;
                    }
#undef CMP
#undef CMP1
#undef LDG
#undef SB
                }
            } else {
                u32x2 N[2][9];
#pragma unroll
                for (int pp = 0; pp < 2; ++pp)
#pragma unroll
                    for (int k = 0; k < 9; ++k) N[pp][k] = (u32x2){0u, 0u};
                LOAD_PREP(it + 1, it - 1, N)
                const f32x4 mu_r = HC4(0), mu_k = HC4(1), mu_v = HC4(2), kkw = HC4(3), kaw = HC4(4), rkw = HC4(5), lnw = HC4(6), lnb = HC4(7);
#define UNPK(w) ((f32x4){bflo((w).x), bfhi((w).x), bflo((w).y), bfhi((w).y)})
#define ROWSUM16(v) { v += dpp_f(v, 0); v += dpp_f(v, 1); v += dpp_f(v, 2); v += dpp_f(v, 3); }
                if (it >= 2) {
                    const int c = it - 2, buf = c & 1;
#pragma unroll
                    for (int pp = 0; pp < 2; ++pp) { const int s = (2 * hw + pp) * 4 + hss;
                        const int row = row0 + c * 16 + s;
                        const f32x4 y = *(const f32x4*)(ybuf + ((buf * 2 + hd) * 16 + s) * 64 + hc4);
                        float sm = (y[0] + y[1]) + (y[2] + y[3]); ROWSUM16(sm)
                        const float mean = sm * (1.f / 64.f);
                        const f32x4 d = y - mean;
                        float sq = (d[0] * d[0] + d[1] * d[1]) + (d[2] * d[2] + d[3] * d[3]); ROWSUM16(sq)
                        const float rs = rsqrtf(sq * (1.f / 64.f) + 64e-5f);
                        const f32x4 vv = *(const f32x4*)(vec + (size_t)((buf * 2 + hd) * 16 + s) * 384 + 128 + hc4);
                        const float bo = bon[(buf * 2 + hd) * 16 + s];
                        const f32x4 g = UNPK(__builtin_bit_cast(u32x2, PFU(pp, 8)));
                        const f32x4 o = (d * rs * lnw + lnb + bo * vv) * g;
                        *(u32x2*)(BRc + (size_t)row * BR + hcol4) = (u32x2){pk_bf16(o[0], o[1]), pk_bf16(o[2], o[3])};
                    }
                }
                if (it < nch) {
                    const int c = it, buf = c & 1;
#pragma unroll
                    for (int pp = 0; pp < 2; ++pp) { const int s = (2 * hw + pp) * 4 + hss;
                        const f32x4 rc = UNPK(__builtin_bit_cast(u32x2, PFU(pp, 0))), kc = UNPK(__builtin_bit_cast(u32x2, PFU(pp, 1))), vc = UNPK(__builtin_bit_cast(u32x2, PFU(pp, 2)));
                        const f32x4 rp = UNPK(__builtin_bit_cast(u32x2, PFU(pp, 3))), kp = UNPK(__builtin_bit_cast(u32x2, PFU(pp, 4))), vp = UNPK(__builtin_bit_cast(u32x2, PFU(pp, 5)));
                        const h16x4 eh = __builtin_bit_cast(h16x4, PFU(pp, 6)), ah = __builtin_bit_cast(h16x4, PFU(pp, 7));
                        const f32x4 r = rc + mu_r * (rp - rc), k = kc + mu_k * (kp - kc), v = vc + mu_v * (vp - vc);
                        const f32x4 aa = {(float)ah[0], (float)ah[1], (float)ah[2], (float)ah[3]};
                        const f32x4 dec = {__expf(-(float)eh[0]), __expf(-(float)eh[1]), __expf(-(float)eh[2]), __expf(-(float)eh[3])};
                        const f32x4 kkr = k * kkw;
                        float n2 = (kkr[0] * kkr[0] + kkr[1] * kkr[1]) + (kkr[2] * kkr[2] + kkr[3] * kkr[3]); ROWSUM16(n2)
                        const f32x4 kk = kkr * rsqrtf(fmaxf(n2, 1e-24f));
                        const f32x4 kpr = k * (1.f + (aa - 1.f) * kaw);
                        const f32x4 bbv = kk * aa;
                        const f32x4 bt = r * kpr * rkw;
                        float bonus = (bt[0] + bt[1]) + (bt[2] + bt[3]); ROWSUM16(bonus)
                        float* vs = vec + (size_t)((buf * 2 + hd) * 16 + s) * 384 + hc4;
                        *(f32x4*)vs = r; *(f32x4*)(vs + 64) = kpr; *(f32x4*)(vs + 128) = v; *(f32x4*)(vs + 192) = dec; *(f32x4*)(vs + 256) = kk; *(f32x4*)(vs + 320) = bbv;
                        if ((lane & 15) == 0) bon[(buf * 2 + hd) * 16 + s] = bonus;
                    }
                }
#undef UNPK
#undef ROWSUM16
#pragma unroll
                for (int pp = 0; pp < 2; ++pp)
#pragma unroll
                    for (int k = 0; k < 9; ++k) PFU(pp, k) = __builtin_bit_cast(f32x2, N[pp][k]);
            }
            __syncthreads();
        }
#undef LOAD_PREP
        if (is_scan) {
            float* so = a.out + (smp ? O_SS : O_PS) + ((size_t)bh * 64 + srow) * 64 + cb;
#pragma unroll
            for (int j = 0; j < 8; ++j) *(f32x4*)(so + 4 * j) = (f32x4){S2[2 * j].x, S2[2 * j].y, S2[2 * j + 1].x, S2[2 * j + 1].y};
        }
#undef PFU
#undef HC4
    }
    __builtin_amdgcn_s_setprio(0);
}

struct AUnit {
    int qrow0, nqw, qcol, ntiles, lim0, causal, last_valid, ld;
    const bf16_t* kb; const bf16_t* vb;
};
constexpr int A_KRS = 272, A_VRS = 320, A_KT = 64 * A_KRS, A_VT = 64 * A_VRS, A_BUF = A_KT + A_VT;

__device__ __forceinline__ void attn_load1(const bf16_t* __restrict__ src, int ld, int t, u32x4 (&r)[2]) {
    const int tid = threadIdx.x;
#pragma unroll
    for (int i = 0; i < 2; ++i) {
        const int c = tid + NTHR * i, key = c >> 4, ch = c & 15;
        r[i] = *(const u32x4*)(src + (size_t)(t * 64 + key) * ld + ch * 8);
    }
}
__device__ __forceinline__ void attn_store1(unsigned char* buf, int rs, const u32x4 (&r)[2]) {
    const int tid = threadIdx.x;
#pragma unroll
    for (int i = 0; i < 2; ++i) {
        const int c = tid + NTHR * i, key = c >> 4, ch = c & 15;
        *(u32x4*)(buf + key * rs + ch * 16) = r[i];
    }
}

template <int NS, int SI>
__device__ __forceinline__ void attn_stream(const unsigned char* kbase, const unsigned char* vbase, const unsigned char* q_rd, bool mask_tail, int last_valid, int hh, float sc,
                                            f32x16 (&O)[4], float& mrun, float& lrun) {
    f32x16 S0, S1;
#pragma unroll
    for (int r = 0; r < 16; ++r) { S0[r] = 0.f; S1[r] = 0.f; }
#pragma unroll
    for (int k2 = 0; k2 < 8 / NS; ++k2) {
        const int ks = SI * (8 / NS) + k2;
        if (k2 == 2 || k2 == 4 || k2 == 6) __builtin_amdgcn_sched_barrier(0);
        const bf16x8 qf = *(const bf16x8*)(q_rd + ks * 32);
        const bf16x8 k0 = *(const bf16x8*)(kbase + ks * 32);
        const bf16x8 k1 = *(const bf16x8*)(kbase + 32 * A_KRS + ks * 32);
        S0 = __builtin_amdgcn_mfma_f32_32x32x16_bf16(k0, qf, S0, 0, 0, 0);
        S1 = __builtin_amdgcn_mfma_f32_32x32x16_bf16(k1, qf, S1, 0, 0, 0);
    }
    __builtin_amdgcn_sched_barrier(0);
    if (mask_tail) {
        const int thr = last_valid - 4 * hh;
#pragma unroll
        for (int r = 0; r < 16; ++r) { if ((r & 3) + 8 * (r >> 2) >= thr) S0[r] = -1e30f; if (32 + (r & 3) + 8 * (r >> 2) >= thr) S1[r] = -1e30f; }
    }
    float mx = __builtin_amdgcn_fmed3f(S0[0], S1[0], __builtin_inff());
#pragma unroll
    for (int r = 1; r < 16; ++r) { mx = __builtin_amdgcn_fmed3f(mx, S0[r], __builtin_inff()); mx = __builtin_amdgcn_fmed3f(mx, S1[r], __builtin_inff()); }
    mx = fmaxf(mx, __shfl_xor(mx, 32));
    const float mn = fmaxf(mrun, mx * sc);
    const float alpha = __builtin_amdgcn_exp2f(mrun - mn);
    mrun = mn;
    f32x2 ls2 = {0.f, 0.f};
    const f32x2 sc2 = {sc, sc}, mn2 = {mn, mn};
#pragma unroll
    for (int r = 0; r < 16; r += 2) {
        const f32x2 t0 = (f32x2){S0[r], S0[r + 1]} * sc2 - mn2, t1 = (f32x2){S1[r], S1[r + 1]} * sc2 - mn2;
        const f32x2 p0 = {__builtin_amdgcn_exp2f(t0.x), __builtin_amdgcn_exp2f(t0.y)}, p1 = {__builtin_amdgcn_exp2f(t1.x), __builtin_amdgcn_exp2f(t1.y)};
        S0[r] = p0.x; S0[r + 1] = p0.y; S1[r] = p1.x; S1[r + 1] = p1.y; ls2 += p0 + p1;
    }
    lrun = lrun * alpha + (ls2.x + ls2.y);
    if (__any(alpha != 1.0f)) {
#pragma unroll
        for (int d = 0; d < 4; ++d) O[d] = O[d] * alpha;
    }
#define PV_GROUP(SX, kb, s2) { \
        u32x4 pp; pp.x = pk_bf16(SX[8 * (s2) + 0], SX[8 * (s2) + 1]); pp.y = pk_bf16(SX[8 * (s2) + 2], SX[8 * (s2) + 3]); \
        pp.z = pk_bf16(SX[8 * (s2) + 4], SX[8 * (s2) + 5]); pp.w = pk_bf16(SX[8 * (s2) + 6], SX[8 * (s2) + 7]); \
        const bf16x8 pf = __builtin_bit_cast(bf16x8, pp); \
        const unsigned char* vb0 = vbase + ((kb) * 32 + (s2) * 16) * A_VRS; \
        _Pragma("unroll") for (int d = 0; d < 4; ++d) { \
            if (d == 2) __builtin_amdgcn_sched_barrier(0); \
            const s16x4 lo = __builtin_amdgcn_ds_read_tr16_b64_v4i16((LAS s16x4*)(vb0 + d * 64)); \
            const s16x4 hi = __builtin_amdgcn_ds_read_tr16_b64_v4i16((LAS s16x4*)(vb0 + 8 * A_VRS + d * 64)); \
            const bf16x8 vf = {lo[0], lo[1], lo[2], lo[3], hi[0], hi[1], hi[2], hi[3]}; \
            O[d] = __builtin_amdgcn_mfma_f32_32x32x16_bf16(vf, pf, O[d], 0, 0, 0); } \
        __builtin_amdgcn_sched_barrier(0); }
    __builtin_amdgcn_sched_barrier(0);
    PV_GROUP(S0, 0, 0) PV_GROUP(S0, 0, 1) PV_GROUP(S1, 1, 0) PV_GROUP(S1, 1, 1)
#undef PV_GROUP
}

template <int NS>
__device__ __forceinline__ void attn_unit(const AUnit& u, unsigned char* lds, const bf16_t* __restrict__ GT, bf16_t* BRc, float sc, float lam, const float* __restrict__ subln) {
    const int tid = threadIdx.x, wid = tid >> 6, lane = tid & 63, l31 = lane & 31, hh = lane >> 5;
    const bool active = wid < u.nqw;
    const int limit = u.causal ? u.lim0 + (wid >> 1) : u.ntiles;
    const int qrow = u.qrow0 + wid * 32 + l31;
    unsigned char* qs = lds + 2 * A_BUF + wid * (32 * A_KRS);
    if (active) {
        const bf16_t* qp = BRc + (size_t)qrow * BR + u.qcol + hh * 64;
#pragma unroll
        for (int i = 0; i < 8; ++i) *(u32x4*)(qs + l31 * A_KRS + hh * 128 + i * 16) = *(const u32x4*)(qp + i * 8);
    }
    const unsigned char* q_rd = qs + l31 * A_KRS + hh * 16;
    f32x16 O0[4], O1[4];
    float m0 = -1e30f, m1 = -1e30f, l0r = 0.f, l1r = 0.f;
#pragma unroll
    for (int d = 0; d < 4; ++d)
#pragma unroll
        for (int r = 0; r < 16; ++r) { O0[d][r] = 0.f; O1[d][r] = 0.f; }
    u32x4 rk[2], rv[2];
    attn_load1(u.kb, u.ld, 0, rk); attn_load1(u.vb, u.ld, 0, rv);
    attn_store1(lds, A_KRS, rk); attn_store1(lds + A_KT, A_VRS, rv);
    __syncthreads();
    const int trq = (lane & 15) >> 2, trp = lane & 3, trblk = (lane >> 4) & 1;
    const int v_rd = A_KT + (4 * hh + trq) * A_VRS + (16 * trblk + 4 * trp) * 2;
    const int k_rd = l31 * A_KRS + hh * 16;
    for (int t = 0; t < u.ntiles; ++t) {
        const int cur = t & 1;
        const bool more = t + 1 < u.ntiles;
        const bool work = active && t < limit;
        const unsigned char* kbase = lds + cur * A_BUF + k_rd;
        const unsigned char* vbase = lds + cur * A_BUF + v_rd;
        const bool mask_tail = (t == u.ntiles - 1) && (u.last_valid < 64);
        unsigned char* nb = lds + (cur ^ 1) * A_BUF;
        if (NS == 2) {
            if (more) attn_load1(u.kb, u.ld, t + 1, rk);
            if (work) attn_stream<NS, 0>(kbase, vbase, q_rd, mask_tail, u.last_valid, hh, sc, O0, m0, l0r);
            if (more) { attn_store1(nb, A_KRS, rk); attn_load1(u.vb, u.ld, t + 1, rk); }
            if (work) attn_stream<NS, 1>(kbase, vbase, q_rd, mask_tail, u.last_valid, hh, sc, O1, m1, l1r);
            if (more) attn_store1(nb + A_KT, A_VRS, rk);
        } else {
            if (more) { attn_load1(u.kb, u.ld, t + 1, rk); attn_load1(u.vb, u.ld, t + 1, rv); }
            if (work) attn_stream<NS, 0>(kbase, vbase, q_rd, mask_tail, u.last_valid, hh, sc, O0, m0, l0r);
            if (more) { attn_store1(nb, A_KRS, rk); attn_store1(nb + A_KT, A_VRS, rv); }
        }
        __syncthreads();
    }
    if (active) {
        float l0 = l0r + __shfl_xor(l0r, 32);
        const float i0 = 1.f / l0;
        float post = 1.f;
        if (NS == 2) {
            float l1 = l1r + __shfl_xor(l1r, 32);
            const float i1 = lam / l1;
            float ss = 0.f;
#pragma unroll
            for (int d = 0; d < 4; ++d)
#pragma unroll
                for (int r = 0; r < 16; ++r) { const float o = O0[d][r] * i0 - O1[d][r] * i1; O0[d][r] = o; ss += o * o; }
            ss += __shfl_xor(ss, 32);
            post = rsqrtf(ss * (1.f / 128.f) + 1e-6f) * (1.0f - 0.35550907f);
        } else {
#pragma unroll
            for (int d = 0; d < 4; ++d) O0[d] = O0[d] * i0;
        }
        const size_t rb = (size_t)qrow * BR + u.qcol;
        __builtin_amdgcn_sched_barrier(0);
#pragma unroll
        for (int d = 0; d < 4; ++d)
#pragma unroll
            for (int rq = 0; rq < 4; ++rq) {
                if ((rq & 1) == 0) __builtin_amdgcn_sched_barrier(0);
                const int dv0 = d * 32 + 8 * rq + 4 * hh;
                const u32x2 g = *(const u32x2*)(GT + rb + dv0);
                f32x4 sv = {1.f, 1.f, 1.f, 1.f};
                if (NS == 2) sv = *(const f32x4*)(subln + dv0);
                const float o0 = O0[d][4 * rq + 0] * post * sv[0] * bflo(g.x), o1 = O0[d][4 * rq + 1] * post * sv[1] * bfhi(g.x);
                const float o2 = O0[d][4 * rq + 2] * post * sv[2] * bflo(g.y), o3 = O0[d][4 * rq + 3] * post * sv[3] * bfhi(g.y);
                u32x2 w; w.x = pk_bf16(o0, o1); w.y = pk_bf16(o2, o3);
                *(u32x2*)(BRc + rb + dv0) = w;
            }
    }
    __syncthreads();
}

__device__ __forceinline__ void mem_attn_units(const Args& a, unsigned char* lds, int li, int first, int stride) {
    const bf16_t* GT = (const bf16_t*)(a.ws + WS_GATE);
    bf16_t* BRc = (bf16_t*)(a.ws + WS_BRANCH);
    const bf16_t* MK = (const bf16_t*)(a.ws + WS_MKB) + (size_t)li * 8192 * 512;
    const bf16_t* MV = (const bf16_t*)(a.ws + WS_MVB) + (size_t)li * 8192 * 512;
    const float sc = 0.08838834764831845f * 1.4426950408889634f;
    for (int j = first; j < 1024 + 64; j += stride) {
        AUnit u; u.causal = 0; u.lim0 = 0; u.ntiles = 4; u.last_valid = 64; u.ld = 512;
        int h, mrow;
        if (j < 1024) { const int pm = j >> 2; h = j & 3; u.qrow0 = pm * 256; u.nqw = 8; mrow = (pm >> 4) * 256; }
        else { const int q = j - 1024, b = q >> 2; h = q & 3; u.qrow0 = MP + b * 32; u.nqw = 1; mrow = 4096 + b * 256; }
        u.qcol = 1536 + h * 128;
        u.kb = MK + (size_t)mrow * 512 + h * 128; u.vb = MV + (size_t)mrow * 512 + h * 128;
        attn_unit<1>(u, lds, GT, BRc, sc, 0.f, nullptr);
    }
}

__device__ __forceinline__ void diff_attn_units(const Args& a, unsigned char* lds) {
    const bf16_t* GT = (const bf16_t*)(a.ws + WS_GATE);
    bf16_t* BRc = (bf16_t*)(a.ws + WS_BRANCH);
    const bf16_t* KB = (const bf16_t*)(a.ws + WS_KB);
    const bf16_t* VB = (const bf16_t*)(a.ws + WS_VB);
    const bf16_t* SK = (const bf16_t*)((const unsigned char*)a.out + T_SK);
    const bf16_t* SV = (const bf16_t*)((const unsigned char*)a.out + T_SV);
    float s1 = 0.f, s2 = 0.f;
    for (int i = 0; i < 64; ++i) { s1 += a.in[27][i] * a.in[28][i]; s2 += a.in[29][i] * a.in[30][i]; }
    const float lam = __expf(s1) - __expf(s2) + 0.35550907f;
    const float sc = 0.125f * 1.4426950408889634f;
    const int G = (int)gridDim.x, bI = (int)blockIdx.x;
    const int n_own = (3072 + G - 1) / G;
    const int n_smp = (192 - (G - 1 - bI) + G - 1) / G;
    for (int it = 0; it < n_own + (n_smp > 0 ? n_smp : 0); ++it) {
        const int j = it < n_own ? it * G + ((it & 1) ? G - 1 - bI : bI) : 3072 + (G - 1 - bI) + (it - n_own) * G;
        if (it < n_own && j >= 3072) continue;
        AUnit u; u.ld = MIXW;
        if (j < 3072) {
            const int qt = 15 - j / 192, bh = j % 192, b = bh / 12, h = bh % 12;
            u.qrow0 = b * 4096 + qt * 256; u.nqw = 8; u.qcol = h * 128; u.ntiles = qt * 4 + 4; u.lim0 = qt * 4 + 1; u.causal = 1; u.last_valid = 64;
            u.kb = KB + (size_t)(b * 4096) * MIXW + h * 128; u.vb = VB + (size_t)(b * 4096) * MIXW + h * 128;
        } else {
            const int bh = j - 3072, b = bh / 12, h = bh % 12;
            u.qrow0 = MP + b * 32; u.nqw = 1; u.qcol = h * 128; u.ntiles = 17; u.lim0 = 0; u.causal = 0; u.last_valid = 32;
            u.kb = SK + (size_t)(b * 1088) * MIXW + h * 128; u.vb = SV + (size_t)(b * 1088) * MIXW + h * 128;
        }
        attn_unit<2>(u, lds, GT, BRc, sc, lam, a.in[31]);
    }
}

__device__ __forceinline__ void phase_sample_kv(const Args& a) {
    const size_t ngr = (size_t)16 * 1088 * 192;
    const bf16_t* KB = (const bf16_t*)(a.ws + WS_KB);
    const bf16_t* VB = (const bf16_t*)(a.ws + WS_VB);
    for (size_t i = (size_t)blockIdx.x * NTHR + threadIdx.x; i < 2 * ngr; i += (size_t)gridDim.x * NTHR) {
        const int kv = i >= ngr; const size_t g = kv ? i - ngr : i;
        const int cg8 = (int)(g % 192); const int key = (int)((g / 192) % 1088); const int b = (int)(g / (192 * 1088));
        u32x4 o = {0u, 0u, 0u, 0u};
        if (key < 1024) {
            const float* s = (kv ? a.in[6] : a.in[5]) + ((size_t)b * 1024 + key) * MIXW + cg8 * 8;
            const f32x4 x0 = *(const f32x4*)s, x1 = *(const f32x4*)(s + 4);
            o = (u32x4){pk_bf16(x0[0], x0[1]), pk_bf16(x0[2], x0[3]), pk_bf16(x1[0], x1[1]), pk_bf16(x1[2], x1[3])};
        } else if (key < 1056) {
            o = *(const u32x4*)((kv ? VB : KB) + (size_t)(MP + b * 32 + key - 1024) * MIXW + cg8 * 8);
        }
        *(u32x4*)((bf16_t*)((unsigned char*)a.out + (kv ? T_SV : T_SK)) + ((size_t)b * 1088 + key) * MIXW + cg8 * 8) = o;
    }
}

__device__ __forceinline__ Args load_args() {
    typedef __attribute__((address_space(4))) const Args* KP;
    KP kp = (KP)__builtin_amdgcn_kernarg_segment_ptr();
    asm volatile("" : "+s"(kp));
    Args r;
#pragma unroll
    for (int i = 0; i < 32; ++i) r.in[i] = kp->in[i];
    r.out = kp->out; r.ws = kp->ws; r.ph_lo = kp->ph_lo; r.ph_hi = kp->ph_hi;
    return r;
}

__global__ void __launch_bounds__(NTHR) mega(Args a) {
    extern __shared__ __attribute__((aligned(16))) unsigned char lds[];
    const int wid = threadIdx.x >> 6, lane = threadIdx.x & 63;
#define PH(n) if ((n) > a.ph_lo && (n) < a.ph_hi) cg::this_grid().sync(); if ((n) >= a.ph_lo && (n) < a.ph_hi)
    PH(0) { const Args A = load_args(); unsigned char* ws = A.ws; unsigned char* ob = (unsigned char*)A.out; (void)ws; (void)ob; phase_prep(A, lds); }
    PH(1) { const Args A = load_args(); unsigned char* ws = A.ws; unsigned char* ob = (unsigned char*)A.out; (void)ws; (void)ob;
            for (int li = 0; li < 2; ++li) {
                EpiMem E{A.out, ws, li};
                gemm_pg8(lds, (const bf16_t*)(ws + WS_HM) + (size_t)li * 4096 * 1024, (const bf16_t*)(ws + WS_WMEM_T) + (size_t)li * 1024 * 1024, 4096, 1024, 1024, E, li ? 128 : 192);
            }
            EpiIn0 E{A.out, ws};
            gemm_pg8(lds, (const bf16_t*)(ob + T_HB), (const bf16_t*)(ws + WS_RWIN_T), MT, RWIN_PAD, 1024, E);
        }
    PH(2) { const Args A = load_args(); unsigned char* ws = A.ws; unsigned char* ob = (unsigned char*)A.out; (void)ws; (void)ob; phase_lora(A); }
    PH(3) { const Args A = load_args(); unsigned char* ws = A.ws; unsigned char* ob = (unsigned char*)A.out; (void)ws; (void)ob; if (blockIdx.x >= 192) mem_attn_units(A, lds, 0, blockIdx.x - 192, gridDim.x - 192); phase_scan(A, lds); }
    PH(4) { const Args A = load_args(); unsigned char* ws = A.ws; unsigned char* ob = (unsigned char*)A.out; (void)ws; (void)ob; EpiOut0 E{A.out};
            gemm_pg8(lds, (const bf16_t*)(ws + WS_BRANCH), (const bf16_t*)(ws + WS_WOUT_T), MT, 1024, 2048, E); }
    PH(5) { const Args A = load_args(); unsigned char* ws = A.ws; unsigned char* ob = (unsigned char*)A.out; (void)ws; (void)ob;
            const int gw = blockIdx.x * 8 + wid, nw = gridDim.x * 8;
            for (int r = gw; r < MT; r += nw)
                norm_row_bf16(xrow(A, r), (const bf16_t*)(ob + T_D0) + (size_t)r * DM, A.in[9] + DM, (bf16_t*)(ob + T_HB) + (size_t)r * DM, nullptr, nullptr, lane);
        }
    PH(6) { const Args A = load_args(); unsigned char* ws = A.ws; unsigned char* ob = (unsigned char*)A.out; (void)ws; (void)ob; EpiIn1 E{A.out, ws};
            gemm_pg8(lds, (const bf16_t*)(ob + T_HB), (const bf16_t*)(ws + WS_DFIN_T), MT, DFIN, 1024, E); }
    PH(7) { const Args A = load_args(); unsigned char* ws = A.ws; unsigned char* ob = (unsigned char*)A.out; (void)ws; (void)ob; phase_sample_kv(A); }
    PH(8) { const Args A = load_args(); unsigned char* ws = A.ws; unsigned char* ob = (unsigned char*)A.out; (void)ws; (void)ob; diff_attn_units(A, lds); mem_attn_units(A, lds, 1, blockIdx.x, gridDim.x); }
    PH(9) { const Args A = load_args(); unsigned char* ws = A.ws; unsigned char* ob = (unsigned char*)A.out; (void)ws; (void)ob; EpiOut1 E{A.in[0], A.in[2], A.out, ws};
            gemm_pg8(lds, (const bf16_t*)(ws + WS_BRANCH), (const bf16_t*)(ws + WS_WOUT_T) + (size_t)1024 * 2048, MT, 1024, 2048, E); }
    PH(10) { const Args A = load_args(); unsigned char* ws = A.ws; unsigned char* ob = (unsigned char*)A.out; (void)ws; (void)ob;
            const int gw = blockIdx.x * 8 + wid, nw = gridDim.x * 8;
            const float* X2 = (const float*)(ws + WS_X2); const float* fw = A.in[14];
            for (int r = gw; r < MT; r += nw) {
                const float* x = X2 + (size_t)r * DM;
                float* o = r < MP ? A.out + O_Y + (size_t)r * DM : A.out + O_YS + (size_t)(r - MP) * DM;
                f32x4 v[4]; float ss = 0.f;
#pragma unroll
                for (int i = 0; i < 4; ++i) { v[i] = __builtin_nontemporal_load((const f32x4*)(x + i * 256 + lane * 4)); ss += v[i][0] * v[i][0] + v[i][1] * v[i][1] + v[i][2] * v[i][2] + v[i][3] * v[i][3]; }
                ss = wave_sum(ss);
                const float rs = rsqrtf(ss * (1.0f / 1024.0f) + 1e-6f);
#pragma unroll
                for (int i = 0; i < 4; ++i) { const f32x4 g = *(const f32x4*)(fw + i * 256 + lane * 4); *(f32x4*)(o + i * 256 + lane * 4) = v[i] * rs * g; }
            }
        }
}

constexpr int N_PHASES = 11;

extern "C" void kernel_launch(void* const* d_in, const int* in_sizes, int n_in, void* d_out, int out_size, void* d_ws, size_t ws_size, hipStream_t stream) {
    static int grid = 0;
    if (grid == 0) {
        int dev = 0, cus = 0, per_cu = 0;
        hipGetDevice(&dev);
        hipDeviceGetAttribute(&cus, hipDeviceAttributeMultiprocessorCount, dev);
        if (hipFuncSetAttribute((const void*)mega, hipFuncAttributeMaxDynamicSharedMemorySize, LDS_BYTES) != hipSuccess) { fprintf(stderr, "hipFuncSetAttribute failed\n"); }
        if (hipOccupancyMaxActiveBlocksPerMultiprocessor(&per_cu, (const void*)mega, NTHR, LDS_BYTES) != hipSuccess || per_cu < 1) { fprintf(stderr, "occupancy query: %d\n", per_cu); per_cu = 1; }
        (void)hipGetLastError();
        grid = cus * 1;
        if (n_in != 32 || ws_size < WS_END) fprintf(stderr, "kernel_launch: unexpected n_in %d / ws %zu (need %zu)\n", n_in, ws_size, (size_t)WS_END);
    }
    Args a{};
    for (int i = 0; i < 32; ++i) a.in[i] = (const float*)d_in[i];
    a.out = (float*)d_out; a.ws = (unsigned char*)d_ws;
#ifdef MULTI_LAUNCH
    for (int ph = 0; ph < N_PHASES; ++ph) { a.ph_lo = ph; a.ph_hi = ph + 1; hipLaunchKernelGGL(mega, dim3(grid), dim3(NTHR), LDS_BYTES, stream, a); }
#else
    a.ph_lo = 0; a.ph_hi = N_PHASES;
    void* args[] = {&a};
    hipError_t e = hipLaunchCooperativeKernel((const void*)mega, dim3(grid), dim3(NTHR), args, LDS_BYTES, stream);
    if (e != hipSuccess) fprintf(stderr, "cooperative launch failed: %s (grid %d)\n", hipGetErrorString(e), grid);
#endif
}
```
